# Optimizing an MI355X kernel written in HIP

```python
import jax, jax.numpy as jnp
from jax import lax
import numpy as np

D_MODEL = 2048
BATCH = 2
SEQ = 8192
DEPTH = 1

ATT_HEADS = 8
ATT_HEAD_DIM = 128
ATT_WIDTH = ATT_HEADS * ATT_HEAD_DIM
DILATION_PATTERNS = ((128, 1), (512, 4), (2048, 16))
BLOCK = 128
MLSTM_HEADS = 4
MLSTM_HEAD_DIM = 256
MLSTM_WIDTH = MLSTM_HEADS * MLSTM_HEAD_DIM
MLSTM_CHUNK = 64
CONV_WIDTH = 4
NORM_EPS = 1e-6
IN_SPLITS = (ATT_WIDTH,) * 4 + (MLSTM_WIDTH,) * 5 + (2 * MLSTM_HEADS, D_MODEL, D_MODEL)
IN_COLS = sum(IN_SPLITS)

kernel_name = 'hybrid_dilated_attn_mlstm_block'


def rmsnorm(x, g):
    xf = x.astype(jnp.float32)
    y = xf * lax.rsqrt(jnp.mean(xf * xf, axis=-1, keepdims=True) + NORM_EPS)
    return (y * g.astype(jnp.float32)).astype(x.dtype)


def alibi_slopes(n_heads):
    return jnp.asarray(2.0 ** (-8.0 * np.arange(1, n_heads + 1) / n_heads), dtype=jnp.float32)


def dilated_band_attention(q, k, v, window, dilation, slopes):
    B, S, H, E = q.shape
    d = dilation
    L = S // d
    nb = -(-L // BLOCK)
    Lp = nb * BLOCK
    w_sub = window // d

    def to_sub(t):
        t = t.reshape(B, L, d, H, E).transpose(0, 2, 1, 3, 4)
        return jnp.pad(t, ((0, 0), (0, 0), (0, Lp - L), (0, 0), (0, 0)))

    def band(t):
        t = jnp.pad(to_sub(t), ((0, 0), (0, 0), (BLOCK, 0), (0, 0), (0, 0)))
        t = t.reshape(B, d, nb + 1, BLOCK, H, E)
        return jnp.concatenate([t[:, :, :-1], t[:, :, 1:]], axis=3)

    qs = to_sub(q).reshape(B, d, nb, BLOCK, H, E)
    kb, vb = band(k), band(v)
    qi = jnp.arange(BLOCK)
    kj = jnp.arange(2 * BLOCK)
    delta = qi[:, None] - kj[None, :] + BLOCK
    key_pos = jnp.arange(nb)[:, None] * BLOCK + kj[None, :] - BLOCK
    valid = (delta >= 0)[None] & (delta <= w_sub)[None] & (key_pos >= 0)[:, None, :]
    alibi = -slopes[:, None, None] * (delta * d).astype(jnp.float32)[None]
    s = jnp.einsum('bdnqhe,bdnkhe->bdnhqk', qs, kb) * (E ** -0.5) + alibi
    s = jnp.where(valid[:, None], s, -jnp.inf)
    lse = jax.nn.logsumexp(s, axis=-1)
    p = jnp.exp(s - lse[..., None])
    o = jnp.einsum('bdnhqk,bdnkhe->bdnqhe', p, vb).reshape(B, d, Lp, H, E)[:, :, :L]
    o = o.transpose(0, 2, 1, 3, 4).reshape(B, S, H, E)
    lse = lse.transpose(0, 1, 2, 4, 3).reshape(B, d, Lp, H)[:, :, :L]
    lse = lse.transpose(0, 2, 1, 3).reshape(B, S, H)
    return o, lse


def dilated_mixture_attention(q, k, v):
    B, S, _ = q.shape
    shp = (B, S, ATT_HEADS, ATT_HEAD_DIM)
    qf, kf, vf = (t.astype(jnp.float32).reshape(shp) for t in (q, k, v))
    slopes = alibi_slopes(ATT_HEADS)
    outs, lses = [], []
    for window, dilation in DILATION_PATTERNS:
        o, lse = dilated_band_attention(qf, kf, vf, window, dilation, slopes)
        outs.append(o)
        lses.append(lse)
    wts = jax.nn.softmax(jnp.stack(lses, axis=-1), axis=-1)
    o = jnp.einsum('bshp,pbshe->bshe', wts, jnp.stack(outs, axis=0))
    return o.reshape(B, S, ATT_WIDTH).astype(q.dtype)


def causal_depthwise_conv(x, w, b):
    K = w.shape[0]
    S = x.shape[1]
    xp = jnp.pad(x, ((0, 0), (K - 1, 0), (0, 0)))
    y = b
    for j in range(K):
        y = y + w[j] * xp[:, j:j + S]
    return y


def mlstm_chunkwise(q, k, v, i_pre, f_pre):
    B, S, H, E = q.shape
    L = MLSTM_CHUNK
    nc = S // L
    q = q.astype(jnp.float32)
    k = k.astype(jnp.float32) * (E ** -0.5)
    v = v.astype(jnp.float32)
    ig = i_pre.astype(jnp.float32)
    logf = jax.nn.log_sigmoid(f_pre.astype(jnp.float32))

    def chunks(t):
        return t.reshape((B, nc, L) + t.shape[2:]).swapaxes(0, 1).swapaxes(2, 3)

    tril = jnp.tril(jnp.ones((L, L), dtype=bool))

    def step(carry, xs):
        C, n, m = carry
        qc, kc, vc, ic, fc = xs
        b = jnp.cumsum(fc, axis=-1)
        dmat = jnp.where(tril, b[..., :, None] - b[..., None, :] + ic[..., None, :], -jnp.inf)
        inter = b + m[..., None]
        m_t = jnp.maximum(inter, jnp.max(dmat, axis=-1))
        w_intra = jnp.exp(dmat - m_t[..., None])
        w_inter = jnp.exp(inter - m_t)
        s = jnp.einsum('bhte,bhse->bhts', qc, kc) * w_intra
        num = jnp.einsum('bhts,bhse->bhte', s, vc) + w_inter[..., None] * jnp.einsum('bhte,bhef->bhtf', qc, C)
        den = jnp.sum(s, axis=-1) + w_inter * jnp.einsum('bhte,bhe->bht', qc, n)
        h = num / jnp.maximum(jnp.abs(den), jnp.exp(-m_t))[..., None]
        b_last = b[..., -1]
        w_log = b_last[..., None] - b + ic
        m_new = jnp.maximum(b_last + m, jnp.max(w_log, axis=-1))
        w_k = jnp.exp(w_log - m_new[..., None])
        decay = jnp.exp(b_last + m - m_new)
        C = decay[..., None, None] * C + jnp.einsum('bhs,bhse,bhsf->bhef', w_k, kc, vc)
        n = decay[..., None] * n + jnp.einsum('bhs,bhse->bhe', w_k, kc)
        return (C, n, m_new), h

    init = (jnp.zeros((B, H, E, E), jnp.float32), jnp.zeros((B, H, E), jnp.float32),
            jnp.zeros((B, H), jnp.float32))
    _, h = lax.scan(step, init, (chunks(q), chunks(k), chunks(v), chunks(ig), chunks(logf)))
    return h.swapaxes(2, 3).swapaxes(0, 1).reshape(B, S, H, E)


def head_layernorm(h, g):
    mu = jnp.mean(h, axis=-1, keepdims=True)
    var = jnp.mean(jnp.square(h - mu), axis=-1, keepdims=True)
    y = (h - mu) * lax.rsqrt(var + NORM_EPS)
    B, S, H, E = h.shape
    return y.reshape(B, S, H * E) * g.astype(jnp.float32)


def setup_inputs(seed: int = 0) -> dict:
    key = jax.random.key(seed)
    ks = jax.random.split(key, 16)
    nrm = jax.random.normal
    f32 = jnp.float32
    x = nrm(ks[0], (BATCH, SEQ, D_MODEL), f32)
    c = nrm(ks[1], (BATCH, D_MODEL), f32)
    norm_gain = 1.0 + 0.02 * nrm(ks[2], (DEPTH, D_MODEL), f32)
    w_ada = nrm(ks[3], (DEPTH, D_MODEL, 3 * D_MODEL), f32) * (0.5 * D_MODEL ** -0.5)
    b_ada = 0.02 * nrm(ks[4], (DEPTH, 3 * D_MODEL), f32)
    w_in = nrm(ks[5], (DEPTH, D_MODEL, IN_COLS), f32) * (D_MODEL ** -0.5)
    b_i = 0.1 * nrm(ks[6], (DEPTH, MLSTM_HEADS), f32)
    b_f = jnp.linspace(3.0, 6.0, MLSTM_HEADS, dtype=f32)[None] + 0.1 * nrm(ks[7], (DEPTH, MLSTM_HEADS), f32)
    b_gate_if = jnp.concatenate([b_i, b_f], axis=-1)
    conv_w = nrm(ks[8], (DEPTH, CONV_WIDTH, 2 * MLSTM_WIDTH), f32) * (CONV_WIDTH ** -0.5)
    conv_b = 0.02 * nrm(ks[9], (DEPTH, 2 * MLSTM_WIDTH), f32)
    mlstm_norm_gain = 1.0 + 0.02 * nrm(ks[10], (DEPTH, MLSTM_WIDTH), f32)
    w_proj_attn = nrm(ks[11], (DEPTH, ATT_WIDTH, D_MODEL), f32) * (ATT_WIDTH ** -0.5)
    w_proj_mlstm = nrm(ks[12], (DEPTH, MLSTM_WIDTH, D_MODEL), f32) * (MLSTM_WIDTH ** -0.5)
    w_out = nrm(ks[13], (DEPTH, D_MODEL, D_MODEL), f32) * (D_MODEL ** -0.5)
    final_gain = 1.0 + 0.02 * nrm(ks[14], (D_MODEL,), f32)
    return {'x': x, 'c': c, 'norm_gain': norm_gain, 'w_ada': w_ada, 'b_ada': b_ada, 'w_in': w_in,
            'b_gate_if': b_gate_if, 'conv_w': conv_w, 'conv_b': conv_b,
            'mlstm_norm_gain': mlstm_norm_gain, 'w_proj_attn': w_proj_attn,
            'w_proj_mlstm': w_proj_mlstm, 'w_out': w_out, 'final_gain': final_gain}


def reference(x, c, norm_gain, w_ada, b_ada, w_in, b_gate_if, conv_w, conv_b, mlstm_norm_gain,
              w_proj_attn, w_proj_mlstm, w_out, final_gain):
    offsets = [int(o) for o in np.cumsum(IN_SPLITS)[:-1]]
    for l in range(DEPTH):
        mod = c @ w_ada[l] + b_ada[l]
        shift, scale, gate = jnp.split(mod, 3, axis=-1)
        h = rmsnorm(x, norm_gain[l]) * (1.0 + scale[:, None]) + shift[:, None]
        proj = h @ w_in[l]
        qa, ka, va, za, qm, km, vm, om, zm, ifg, ga, gb = jnp.split(proj, offsets, axis=-1)
        attn = dilated_mixture_attention(qa, ka, va)
        ya = (attn * jax.nn.silu(za)) @ w_proj_attn[l]
        qk = jax.nn.silu(causal_depthwise_conv(jnp.concatenate([qm, km], axis=-1), conv_w[l], conv_b[l]))
        qm_c, km_c = jnp.split(qk, 2, axis=-1)
        ifg = ifg + b_gate_if[l]
        i_pre, f_pre = ifg[..., :MLSTM_HEADS], ifg[..., MLSTM_HEADS:]
        B, S, _ = x.shape
        shp = (B, S, MLSTM_HEADS, MLSTM_HEAD_DIM)
        h_tilde = mlstm_chunkwise(qm_c.reshape(shp), km_c.reshape(shp), vm.reshape(shp), i_pre, f_pre)
        h_cell = jax.nn.sigmoid(om.astype(jnp.float32)).reshape(shp) * h_tilde
        hm = head_layernorm(h_cell, mlstm_norm_gain[l]).astype(x.dtype)
        yb = (hm * jax.nn.silu(zm)) @ w_proj_mlstm[l]
        merged = jax.nn.sigmoid(ga) * ya + jax.nn.sigmoid(gb) * yb
        out = merged @ w_out[l]
        x = x + gate[:, None] * out
    return rmsnorm(x, final_gain)
```

```cpp
#include <hip/hip_runtime.h>
#include <hip/hip_cooperative_groups.h>
#include <cstdio>
#include <cstdint>
namespace cg = cooperative_groups;

typedef unsigned short u16;
typedef short bf16x8 __attribute__((ext_vector_type(8)));
typedef float f32x4 __attribute__((ext_vector_type(4)));
typedef unsigned u32x4 __attribute__((ext_vector_type(4)));
typedef unsigned u32x2 __attribute__((ext_vector_type(2)));

#define PROBE_DUP 0
#define USE_GM 1
#define DEV __device__ __forceinline__
__device__ __forceinline__ int threadIdx_x_raw() { return (int)threadIdx.x; }
DEV int ltid() { int t = threadIdx_x_raw(); asm volatile("" : "+v"(t)); return t; }
#define UNR _Pragma("unroll")
#define RELANE int l_ = ltid() & 63; asm volatile("" : "+v"(l_)); const int fr = l_ & 15, fq = l_ >> 4; (void)fr; (void)fq
template <class T> __device__ __forceinline__ T* launder(T* p) { asm volatile("" : "+s"(p)); return p; }

constexpr int NTOK = 16384, DM = 2048, SEQ = 8192, INC = 13320;
constexpr int NTHR = 512;
constexpr int LDS_BYTES = 159744;
constexpr size_t MBy = 1ull << 20;
constexpr size_t OFF_MODP = 576 * 1024;
constexpr size_t OFF_MOD = 0, OFF_BAR = 49152, OFF_IFG = 64 * 1024, OFF_LSE = 1 * MBy;
constexpr int OFF_LDS_ST = 159488;
constexpr size_t OFF_SA = 2 * MBy + 512 * 1024, OFF_SC = OFF_SA + 256 * 1024, OFF_SCM = OFF_SC + 256 * 1024;
constexpr size_t OFF_IA = 3 * MBy + 256 * 1024, OFF_IG = OFF_IA + 4096, OFF_MK = OFF_IG + 4096;
constexpr size_t OFF_NU = 3 * MBy + 512 * 1024, OFF_NK = OFF_NU + 256 * 1024;
constexpr size_t OFF_WPA = 4 * MBy, OFF_WPM = 8 * MBy, OFF_WOUT = 12 * MBy, OFF_WG = 20 * MBy, OFF_WMAIN = 36 * MBy;
constexpr size_t OFF_H = 72 * MBy, OFF_P3 = 136 * MBy, OFF_P1 = 232 * MBy, OFF_P2 = 328 * MBy;
constexpr size_t OFF_QC = 424 * MBy, OFF_KC = 456 * MBy, WS_NEED = 488 * MBy;
constexpr size_t OFF_KWT = OFF_WMAIN;
constexpr size_t OFF_U = 232 * MBy, OFF_CT = 296 * MBy, OFF_PB = 328 * MBy, OFF_AA = 360 * MBy, OFF_AM = 392 * MBy;
constexpr size_t OFF_P4 = 232 * MBy;
constexpr size_t OFF_MG = 424 * MBy;
constexpr size_t OFF_DL = 360 * MBy;
constexpr size_t DO_OATT = 0, DO_VT = 96 * MBy;

struct Params {
  const float *x, *c, *norm_gain, *w_ada, *b_ada, *w_in, *b_gate_if, *conv_w, *conv_b, *mgain, *w_pa, *w_pm, *w_out, *fgain;
  float* out; char* ws;
};

DEV float bf2f(u16 v) { return __uint_as_float(((unsigned)v) << 16); }
DEV float bflo(unsigned u) { return __uint_as_float(u << 16); }
DEV float bfhi(unsigned u) { return __uint_as_float(u & 0xffff0000u); }
typedef float f32x2_ __attribute__((ext_vector_type(2)));
typedef __bf16 bf16x2_ __attribute__((ext_vector_type(2)));
DEV unsigned pk_bf16(float lo, float hi) { f32x2_ v = {lo, hi}; bf16x2_ b = __builtin_convertvector(v, bf16x2_); return __builtin_bit_cast(unsigned, b); }
DEV float sigmoidf_(float v) { return __builtin_amdgcn_rcpf(1.0f + __expf(-v)); }
DEV float siluf_(float v) { return v * __builtin_amdgcn_rcpf(1.0f + __expf(-v)); }
DEV float wave_sum(float v) {
  v += __int_as_float(__builtin_amdgcn_update_dpp(0, __float_as_int(v), 0xB1, 0xf, 0xf, true));
  v += __int_as_float(__builtin_amdgcn_update_dpp(0, __float_as_int(v), 0x4E, 0xf, 0xf, true));
  v += __int_as_float(__builtin_amdgcn_update_dpp(0, __float_as_int(v), 0x141, 0xf, 0xf, true));
  v += __int_as_float(__builtin_amdgcn_update_dpp(0, __float_as_int(v), 0x140, 0xf, 0xf, true));
  return __int_as_float(__builtin_amdgcn_readlane(__float_as_int(v), 0)) + __int_as_float(__builtin_amdgcn_readlane(__float_as_int(v), 16)) +
         __int_as_float(__builtin_amdgcn_readlane(__float_as_int(v), 32)) + __int_as_float(__builtin_amdgcn_readlane(__float_as_int(v), 48));
}
DEV int perm32(int rho) { const int n = rho >> 4, i = rho & 15; return 8 * (i >> 2) + 4 * n + (i & 3); }

constexpr int BK = 64, HALF = 128, HT = HALF * BK;
DEV int lds_byte(int r, int c) { int st = (r >> 4) * 2 + (c >> 5), rr = r & 15, cc = c & 31, ob = rr * 64 + cc * 2; return st * 1024 + (ob ^ (((ob >> 9) & 1) << 5)); }
DEV void stage_rc(int b, int& R, int& C) { int st = b / 1024, sb = b % 1024, swz = sb ^ (((sb >> 9) & 1) << 5); R = (st >> 1) * 16 + swz / 64; C = (st & 1) * 32 + (swz % 64) / 2; }

#define LAS __attribute__((address_space(3)))
typedef LAS char lchar;
constexpr int HTB = HT * 2;
#define SA_(b, h) (((b) * 2 + (h)) * HTB)
#define SB_(b, h) ((4 + (b) * 2 + (h)) * HTB)
#define STAGE(bufoff, gbase, voff) do { _Pragma("unroll") for (int _i = 0; _i < 2; ++_i) \
    __builtin_amdgcn_global_load_lds((const unsigned*)((const char*)(gbase) + (voff)[_i]), (LAS unsigned*)(lds + (bufoff) + ldsw + _i * 8192), 16, 0, 0); } while (0)
#define LDA(dst, b, h) do { _Pragma("unroll") for (int m = 0; m < 4; ++m) _Pragma("unroll") for (int k = 0; k < 2; ++k) dst[m][k] = *(const LAS bf16x8*)(lds + SA_(b, h) + aoff + m * 2048 + k * 1024); } while (0)
#define LDB(dst, b, h) do { _Pragma("unroll") for (int n = 0; n < 2; ++n) _Pragma("unroll") for (int k = 0; k < 2; ++k) dst[n][k] = *(const LAS bf16x8*)(lds + SB_(b, h) + boff + n * 2048 + k * 1024); } while (0)
#define MMA(ai, bj, At, Bx) do { __builtin_amdgcn_s_setprio(1); _Pragma("unroll") for (int m = 0; m < 4; ++m) _Pragma("unroll") for (int n = 0; n < 2; ++n) _Pragma("unroll") for (int k = 0; k < 2; ++k) \
      acc[ai][bj][m][n] = __builtin_amdgcn_mfma_f32_16x16x32_bf16(Bx[n][k], At[m][k], acc[ai][bj][m][n], 0, 0, 0); \
    __builtin_amdgcn_s_setprio(0); } while (0)
#define WAIT_V(n) asm volatile("s_waitcnt vmcnt(" #n ")" ::: "memory")
#define WAIT_L(n) asm volatile("s_waitcnt lgkmcnt(" #n ")" ::: "memory")
#define BAR __builtin_amdgcn_s_barrier()
#define SCHED __builtin_amdgcn_sched_barrier(0)

DEV void gemm_kloop(f32x4 (&acc)[2][2][4][2], const u16* A, int lda, const u16* Bt, int ldb, int K, lchar* lds) {
  const int tid = ltid(), wid = __builtin_amdgcn_readfirstlane(tid >> 6), lane = tid & 63, wr = wid >> 2, wc = wid & 3, fr = lane & 15, fq = lane >> 4;
  unsigned voffA[2], voffB[2];
#pragma unroll
  for (int i = 0; i < 2; ++i) { int R, C; stage_rc(tid * 16 + i * 8192, R, C); const int Rb = (R & ~31) + perm32(R & 31); voffA[i] = (unsigned)(R * lda + C) * 2u; voffB[i] = (unsigned)(Rb * ldb + C) * 2u; }
  const size_t kstep = (size_t)(BK * 2), hA = (size_t)HALF * lda * 2, hB = (size_t)HALF * ldb * 2;
  const unsigned ldsw = (unsigned)wid * 1024u;
  const int aoff = lds_byte(wr * 64 + fr, fq * 8), boff = lds_byte(wc * 32 + fr, fq * 8);
  const char* cA = (const char*)A; const char* cB = (const char*)Bt;
  bf16x8 At[4][2], B0[2][2], B1[2][2];
  const int nt = K / BK;
  STAGE(SB_(0, 0), cB, voffB); STAGE(SA_(0, 0), cA, voffA); STAGE(SB_(0, 1), cB + hB, voffB); STAGE(SA_(0, 1), cA + hA, voffA);
  if (wr == 1) BAR;
  WAIT_V(4); BAR;
  STAGE(SB_(1, 0), cB + kstep, voffB); STAGE(SA_(1, 0), cA + kstep, voffA); STAGE(SB_(1, 1), cB + hB + kstep, voffB);
  WAIT_V(6); BAR;
  for (int t = 0; t < nt - 2; t += 2) {
    const char* a1 = cA + (size_t)(t + 1) * kstep; const char* a2 = a1 + kstep; const char* a3 = a2 + kstep;
    const char* b2 = cB + (size_t)(t + 2) * kstep; const char* b3 = b2 + kstep;
    LDB(B0, 0, 0); SCHED; LDA(At, 0, 0); STAGE(SA_(1, 1), a1 + hA, voffA);
    WAIT_L(8); BAR; WAIT_L(0); MMA(0, 0, At, B0); BAR; SCHED;
    LDB(B1, 0, 1); STAGE(SB_(0, 0), b2, voffB);
    BAR; WAIT_L(0); MMA(0, 1, At, B1); BAR;
    LDA(At, 0, 1); STAGE(SA_(0, 0), a2, voffA);
    BAR; WAIT_L(0); MMA(1, 0, At, B0); BAR; SCHED;
    STAGE(SB_(0, 1), b2 + hB, voffB);
    WAIT_V(6); BAR; MMA(1, 1, At, B1); BAR;
    LDB(B0, 1, 0); SCHED; LDA(At, 1, 0); STAGE(SA_(0, 1), a2 + hA, voffA);
    WAIT_L(8); BAR; WAIT_L(0); MMA(0, 0, At, B0); BAR; SCHED;
    LDB(B1, 1, 1); STAGE(SB_(1, 0), b3, voffB);
    BAR; WAIT_L(0); MMA(0, 1, At, B1); BAR;
    LDA(At, 1, 1); STAGE(SA_(1, 0), a3, voffA);
    BAR; WAIT_L(0); MMA(1, 0, At, B0); BAR; SCHED;
    STAGE(SB_(1, 1), b3 + hB, voffB);
    WAIT_V(6); BAR; MMA(1, 1, At, B1); BAR;
  }
  { LDB(B0, 0, 0); LDA(At, 0, 0); STAGE(SA_(1, 1), cA + (size_t)(nt - 1) * kstep + hA, voffA);
    BAR; WAIT_L(0); MMA(0, 0, At, B0); BAR;
    LDB(B1, 0, 1); BAR; WAIT_L(0); MMA(0, 1, At, B1); BAR;
    LDA(At, 0, 1); WAIT_V(4); BAR; WAIT_L(0); MMA(1, 0, At, B0); MMA(1, 1, At, B1); BAR; }
  { LDB(B0, 1, 0); LDA(At, 1, 0); WAIT_V(2); BAR; WAIT_L(0); MMA(0, 0, At, B0); BAR;
    LDB(B1, 1, 1); WAIT_V(0); BAR; WAIT_L(0); MMA(0, 1, At, B1); BAR;
    LDA(At, 1, 1); BAR; WAIT_L(0); MMA(1, 0, At, B0); MMA(1, 1, At, B1); BAR; }
  if (wr == 0) BAR;
}

DEV void acc_zero(f32x4 (&acc)[2][2][4][2]) {
  _Pragma("unroll") for (int a = 0; a < 2; ++a) _Pragma("unroll") for (int b = 0; b < 2; ++b) _Pragma("unroll") for (int m = 0; m < 4; ++m) _Pragma("unroll") for (int n = 0; n < 2; ++n) acc[a][b][m][n] = (f32x4){0.f, 0.f, 0.f, 0.f};
}
DEV bool tile_next(int i, int nM, int nN, int& pm, int& pn) {
  const int nwg = nM * nN; const long L = (long)i * gridDim.x + blockIdx.x; if (L >= nwg) return false;
  int wgid = (int)L; { const int q = nwg / 8, r = nwg % 8, xcd = wgid % 8, off = wgid / 8; wgid = (xcd < r ? xcd * (q + 1) : r * (q + 1) + (xcd - r) * q) + off; }
  const int nig = 8 * nN, gid = wgid / nig, fm = gid * 8, gsz = (nM - fm) < 8 ? (nM - fm) : 8;
  pm = fm + ((wgid % nig) % gsz); pn = (wgid % nig) / gsz; return true;
}
template <class Epi>
DEV void gemm_stream(const u16* A, int lda, const u16* Bt, int ldb, int K, int nM, int nN, lchar* lds, Epi&& epi) {
  const int tid = ltid(), wid = __builtin_amdgcn_readfirstlane(tid >> 6), lane = tid & 63, wr = wid >> 2, wc = wid & 3, fr = lane & 15, fq = lane >> 4;
  int pm, pn, npm, npn, ui = 0;
  if (!tile_next(0, nM, nN, pm, pn)) return;
  unsigned voffA[2], voffB[2];
#pragma unroll
  for (int i = 0; i < 2; ++i) { int R, C; stage_rc(tid * 16 + i * 8192, R, C); voffA[i] = (unsigned)(R * lda + C) * 2u; voffB[i] = (unsigned)(R * ldb + C) * 2u; }
  const size_t kstep = (size_t)(BK * 2), hA = (size_t)HALF * lda * 2, hB = (size_t)HALF * ldb * 2, tA = 2 * hA, tB = 2 * hB;
  const unsigned ldsw = (unsigned)wid * 1024u;
  const int aoff = lds_byte(wr * 64 + fr, fq * 8), boff = lds_byte(wc * 32 + fr, fq * 8);
  const int nt = K / BK;
  f32x4 acc[2][2][4][2]; acc_zero(acc);
  bf16x8 At[4][2], B0[2][2], B1[2][2];
  const char* cA = (const char*)A + (size_t)pm * tA; const char* cB = (const char*)Bt + (size_t)pn * tB;
  STAGE(SB_(0, 0), cB, voffB); STAGE(SB_(0, 1), cB + hB, voffB); STAGE(SA_(0, 0), cA, voffA); STAGE(SA_(0, 1), cA + hA, voffA);
  if (wr == 1) BAR;
  WAIT_V(2); BAR;
  STAGE(SB_(1, 0), cB + kstep, voffB); STAGE(SA_(1, 0), cA + kstep, voffA); STAGE(SB_(1, 1), cB + hB + kstep, voffB);
  WAIT_V(6); BAR;
  for (;;) {
    const bool has_next = tile_next(ui + 1, nM, nN, npm, npn);
    const char* nA = has_next ? (const char*)A + (size_t)npm * tA : cA; const char* nB = has_next ? (const char*)Bt + (size_t)npn * tB : cB;
    for (int t = 0; t < nt; t += 2) {
      const bool last = (t == nt - 2);
      const char* a1 = cA + (size_t)(t + 1) * kstep;
      const char* a2 = last ? nA : cA + (size_t)(t + 2) * kstep; const char* b2 = last ? nB : cB + (size_t)(t + 2) * kstep;
      const char* a3 = a2 + kstep; const char* b3 = b2 + kstep;
      LDB(B0, 0, 0); LDB(B1, 0, 1); SCHED; LDA(At, 0, 0); STAGE(SA_(1, 1), a1 + hA, voffA);
      WAIT_V(8); WAIT_L(0); BAR; MMA(0, 0, At, B0); MMA(0, 1, At, B1); BAR; SCHED;
      LDA(At, 0, 1); STAGE(SB_(0, 0), b2, voffB); STAGE(SB_(0, 1), b2 + hB, voffB); STAGE(SA_(0, 0), a2, voffA);
      WAIT_V(8); WAIT_L(0); BAR; MMA(1, 0, At, B0); MMA(1, 1, At, B1); BAR; SCHED;
      LDB(B0, 1, 0); LDB(B1, 1, 1); SCHED; LDA(At, 1, 0); STAGE(SA_(0, 1), a2 + hA, voffA);
      WAIT_V(8); WAIT_L(0); BAR; MMA(0, 0, At, B0); MMA(0, 1, At, B1); BAR; SCHED;
      LDA(At, 1, 1); STAGE(SB_(1, 0), b3, voffB); STAGE(SB_(1, 1), b3 + hB, voffB); STAGE(SA_(1, 0), a3, voffA);
      WAIT_V(8); WAIT_L(0); BAR; MMA(1, 0, At, B0); MMA(1, 1, At, B1); BAR; SCHED;
    }
    if (wr == 0) BAR;
    epi(acc, pm, pn, wr, wc, fr, fq);
    if (!has_next) break;
    acc_zero(acc);
    pm = npm; pn = npn; cA = nA; cB = nB; ++ui;
    if (wr == 1) BAR;
  }
  WAIT_V(0);
  BAR;
}

template <class Epi>
DEV void gemm_stream2(const u16* A0, const u16* A1, int lda, const u16* B0p, const u16* B1p, int ldb, int K, int nM, int nN, lchar* lds, Epi&& epi) {
  const int tid = ltid(), wid = __builtin_amdgcn_readfirstlane(tid >> 6), lane = tid & 63, wr = wid >> 2, wc = wid & 3, fr = lane & 15, fq = lane >> 4;
  int pm, pn, npm, npn, ui = 0;
  if (!tile_next(0, nM, nN, pm, pn)) return;
  unsigned voffA[2], voffB[2];
#pragma unroll
  for (int i = 0; i < 2; ++i) { int R, C; stage_rc(tid * 16 + i * 8192, R, C); voffA[i] = (unsigned)(R * lda + C) * 2u; voffB[i] = (unsigned)(R * ldb + C) * 2u; }
  const size_t kstep = (size_t)(BK * 2), hA = (size_t)HALF * lda * 2, hB = (size_t)HALF * ldb * 2, tA = 2 * hA, tB = 2 * hB;
  const unsigned ldsw = (unsigned)wid * 1024u;
  const int aoff = lds_byte(wr * 64 + fr, fq * 8), boff = lds_byte(wc * 32 + fr, fq * 8);
  const int nt = K / BK;
  f32x4 acc[2][2][4][2]; acc_zero(acc);
  bf16x8 At[4][2], B0[2][2], B1[2][2];
  const char* cA = (const char*)A0 + (size_t)pm * tA; const char* cB = (const char*)B0p + (size_t)pn * tB;
  STAGE(SB_(0, 0), cB, voffB); STAGE(SB_(0, 1), cB + hB, voffB); STAGE(SA_(0, 0), cA, voffA); STAGE(SA_(0, 1), cA + hA, voffA);
  if (wr == 1) BAR;
  WAIT_V(2); BAR;
  STAGE(SB_(1, 0), cB + kstep, voffB); STAGE(SA_(1, 0), cA + kstep, voffA); STAGE(SB_(1, 1), cB + hB + kstep, voffB);
  WAIT_V(6); BAR;
  for (;;) {
    const int seg = ui & 1;
    bool has_next = true; npm = pm; npn = pn;
    if (seg) has_next = tile_next((ui >> 1) + 1, nM, nN, npm, npn);
    const char* nA = has_next ? (const char*)(seg ? A0 : A1) + (size_t)npm * tA : cA; const char* nB = has_next ? (const char*)(seg ? B0p : B1p) + (size_t)npn * tB : cB;
    for (int t = 0; t < nt; t += 2) {
      const bool last = (t == nt - 2);
      const char* a1 = cA + (size_t)(t + 1) * kstep;
      const char* a2 = last ? nA : cA + (size_t)(t + 2) * kstep; const char* b2 = last ? nB : cB + (size_t)(t + 2) * kstep;
      const char* a3 = a2 + kstep; const char* b3 = b2 + kstep;
      LDB(B0, 0, 0); LDB(B1, 0, 1); SCHED; LDA(At, 0, 0); STAGE(SA_(1, 1), a1 + hA, voffA);
      WAIT_V(8); WAIT_L(0); BAR; MMA(0, 0, At, B0); MMA(0, 1, At, B1); BAR; SCHED;
      LDA(At, 0, 1); STAGE(SB_(0, 0), b2, voffB); STAGE(SB_(0, 1), b2 + hB, voffB); STAGE(SA_(0, 0), a2, voffA);
      WAIT_V(8); WAIT_L(0); BAR; MMA(1, 0, At, B0); MMA(1, 1, At, B1); BAR; SCHED;
      LDB(B0, 1, 0); LDB(B1, 1, 1); SCHED; LDA(At, 1, 0); STAGE(SA_(0, 1), a2 + hA, voffA);
      WAIT_V(8); WAIT_L(0); BAR; MMA(0, 0, At, B0); MMA(0, 1, At, B1); BAR; SCHED;
      LDA(At, 1, 1); STAGE(SB_(1, 0), b3, voffB); STAGE(SB_(1, 1), b3 + hB, voffB); STAGE(SA_(1, 0), a3, voffA);
      WAIT_V(8); WAIT_L(0); BAR; MMA(1, 0, At, B0); MMA(1, 1, At, B1); BAR; SCHED;
    }
    if (wr == 0) BAR;
    epi(acc, pm, pn, seg, wr, wc);
    if (!has_next) break;
    if (seg) acc_zero(acc);
    pm = npm; pn = npn; cA = nA; cB = nB; ++ui;
    if (wr == 1) BAR;
  }
  WAIT_V(0);
  BAR;
}

#define STAGE2(bufoff, gbase, lg) do { \
    __builtin_amdgcn_global_load_lds((const unsigned*)((const char*)(gbase) + ((lg) ? vL0 : vS0)), (LAS unsigned*)(lds + (bufoff) + ldsw), 16, 0, 0); \
    __builtin_amdgcn_global_load_lds((const unsigned*)((const char*)(gbase) + ((lg) ? vL1 : vS1)), (LAS unsigned*)(lds + (bufoff) + ldsw + 8192), 16, 0, 0); } while (0)
template <class Epi>
DEV void gemm_stream_gm(const u16* H, const u16* WG, const u16* AA, const u16* AM, const u16* WA, const u16* WM, int nM, int nN, lchar* lds, Epi&& epi) {
  const int tid = ltid(), wid = __builtin_amdgcn_readfirstlane(tid >> 6), lane = tid & 63, wr = wid >> 2, wc = wid & 3, fr = lane & 15, fq = lane >> 4;
  int pm, pn, npm, npn, ui = 0;
  if (!tile_next(0, nM, nN, pm, pn)) return;
  unsigned vL0, vL1, vS0, vS1;
  { int R, C; stage_rc(tid * 16, R, C); vL0 = (unsigned)(R * 2048 + C) * 2u; vS0 = (unsigned)(R * 1024 + C) * 2u;
    stage_rc(tid * 16 + 8192, R, C); vL1 = (unsigned)(R * 2048 + C) * 2u; vS1 = (unsigned)(R * 1024 + C) * 2u; }
  const size_t kstep = (size_t)(BK * 2), hL = (size_t)HALF * 2048 * 2, hS = (size_t)HALF * 1024 * 2;
  const unsigned ldsw = (unsigned)wid * 1024u;
  const int aoff = lds_byte(wr * 64 + fr, fq * 8), boff = lds_byte(wc * 32 + fr, fq * 8);
  f32x4 acc[2][2][4][2]; acc_zero(acc);
  bf16x8 At[4][2], B0[2][2], B1[2][2];
#define GM_A(q, tpm) ((q) < 2 ? (const char*)H + (size_t)(tpm) * 256 * 2048 * 2 : (const char*)((q) == 2 ? AA : AM) + (size_t)(tpm) * 256 * 1024 * 2)
#define GM_B(q, tpn) ((q) < 2 ? (const char*)WG + ((size_t)(q) * 2048 + (size_t)(tpn) * 256) * 2048 * 2 : (const char*)((q) == 2 ? WA : WM) + (size_t)(tpn) * 256 * 1024 * 2)
  const char* cA = GM_A(0, pm); const char* cB = GM_B(0, pn);
  STAGE2(SB_(0, 0), cB, true); STAGE2(SB_(0, 1), cB + hL, true); STAGE2(SA_(0, 0), cA, true); STAGE2(SA_(0, 1), cA + hL, true);
  if (wr == 1) BAR;
  WAIT_V(2); BAR;
  STAGE2(SB_(1, 0), cB + kstep, true); STAGE2(SA_(1, 0), cA + kstep, true); STAGE2(SB_(1, 1), cB + hL + kstep, true);
  WAIT_V(6); BAR;
  bool has_next = true;
#define GM_UNIT(Q, NA, NB) do { \
    const char* nA = (NA); const char* nB = (NB); \
    constexpr bool cl = (Q) < 2, nl = (((Q) + 1) & 3) < 2; constexpr int nt = cl ? 32 : 16; \
    const size_t ch = cl ? hL : hS; \
    for (int t = 0; t < nt; t += 2) { \
      const bool last = (t == nt - 2); \
      const char* a1 = cA + (size_t)(t + 1) * kstep; \
      const char* a2 = last ? nA : cA + (size_t)(t + 2) * kstep; const char* b2 = last ? nB : cB + (size_t)(t + 2) * kstep; \
      const char* a3 = a2 + kstep; const char* b3 = b2 + kstep; \
      const bool wl = last ? nl : cl; const size_t h2 = wl ? hL : hS; \
      LDB(B0, 0, 0); LDB(B1, 0, 1); SCHED; LDA(At, 0, 0); STAGE2(SA_(1, 1), a1 + ch, cl); \
      WAIT_V(8); WAIT_L(0); BAR; MMA(0, 0, At, B0); MMA(0, 1, At, B1); BAR; SCHED; \
      LDA(At, 0, 1); STAGE2(SB_(0, 0), b2, wl); STAGE2(SB_(0, 1), b2 + h2, wl); STAGE2(SA_(0, 0), a2, wl); \
      WAIT_V(8); WAIT_L(0); BAR; MMA(1, 0, At, B0); MMA(1, 1, At, B1); BAR; SCHED; \
      LDB(B0, 1, 0); LDB(B1, 1, 1); SCHED; LDA(At, 1, 0); STAGE2(SA_(0, 1), a2 + h2, wl); \
      WAIT_V(8); WAIT_L(0); BAR; MMA(0, 0, At, B0); MMA(0, 1, At, B1); BAR; SCHED; \
      LDA(At, 1, 1); STAGE2(SB_(1, 0), b3, wl); STAGE2(SB_(1, 1), b3 + h2, wl); STAGE2(SA_(1, 0), a3, wl); \
      WAIT_V(8); WAIT_L(0); BAR; MMA(1, 0, At, B0); MMA(1, 1, At, B1); BAR; SCHED; \
    } \
    if (wr == 0) BAR; \
    epi(acc, pm, pn, (Q), wr, wc); \
    cA = nA; cB = nB; } while (0)
  for (;;) {
    GM_UNIT(0, GM_A(1, pm), GM_B(1, pn)); acc_zero(acc); if (wr == 1) BAR;
    GM_UNIT(1, GM_A(2, pm), GM_B(2, pn)); acc_zero(acc); if (wr == 1) BAR;
    GM_UNIT(2, GM_A(3, pm), GM_B(3, pn)); if (wr == 1) BAR;
    has_next = tile_next(ui + 1, nM, nN, npm, npn);
    GM_UNIT(3, has_next ? GM_A(0, npm) : cA, has_next ? GM_B(0, npn) : cB);
    if (!has_next) break;
    acc_zero(acc); pm = npm; pn = npn; ++ui;
    if (wr == 1) BAR;
  }
  WAIT_V(0);
  BAR;
#undef GM_UNIT
#undef GM_A
#undef GM_B
}

#define ROW_(ai, m) (128 * (ai) + 64 * wr + 16 * (m) + fr)
#define COLP_(bj) (128 * (bj) + 32 * wc + 8 * fq)
#define COLN_(bj, n) (128 * (bj) + 32 * wc + 16 * (n) + 4 * fq)
#define WLANE const int wid = __builtin_amdgcn_readfirstlane(ltid() >> 6), lane = ltid() & 63, wr = wid >> 2, wc = wid & 3, fr = lane & 15, fq = lane >> 4; (void)wid; (void)lane; (void)wr; (void)wc; (void)fr; (void)fq

DEV void phase_prep(const Params& p, char* lds) {
  const int tid = ltid(), wid = tid >> 6, lane = tid & 63;
  float* fl = (float*)lds;
  for (int job = blockIdx.x; job < 192; job += gridDim.x) {
    const int cgp = job % 24, kp = job / 24;
    __syncthreads();
    fl[tid] = p.c[(tid >> 8) * 2048 + kp * 256 + (tid & 255)];
    __syncthreads();
    f32x4 a0 = {0.f, 0.f, 0.f, 0.f}, a1 = {0.f, 0.f, 0.f, 0.f};
    const float* wp = p.w_ada + (size_t)(kp * 256 + wid) * 6144 + cgp * 256 + lane * 4;
#pragma unroll 8
    for (int it = 0; it < 32; ++it) { const f32x4 w = *(const f32x4*)(wp + (size_t)it * 8 * 6144); const int kk = it * 8 + wid; a0 += w * fl[kk]; a1 += w * fl[256 + kk]; }
    float* red = fl + 512;
    *(f32x4*)(red + (wid * 2 + 0) * 256 + lane * 4) = a0; *(f32x4*)(red + (wid * 2 + 1) * 256 + lane * 4) = a1;
    __syncthreads();
    { const int bb = tid >> 8, cc = tid & 255; float s = 0.f;
      UNR for (int w = 0; w < 8; ++w) s += red[(w * 2 + bb) * 256 + cc];
      ((float*)(p.ws + OFF_MODP))[(size_t)(kp * 2 + bb) * 6144 + cgp * 256 + cc] = s; }
  }
  constexpr int T_MAIN = 144 * 32, T_G = 64 * 32, T_PA = 32 * 16, T_PM = 32 * 16, T_OUT = 32 * 32;
  constexpr int T_ALL = T_MAIN + T_G + T_PA + T_PM + T_OUT;
  for (int jg = blockIdx.x; jg < T_ALL / 4; jg += gridDim.x) {
    const float* src; int ld, K, nt_, kt_, scol; u16* dst; int j = jg * 4;
    if (j < T_MAIN) { nt_ = j / 32; kt_ = j % 32; src = p.w_in; ld = INC; K = 2048; dst = (u16*)(p.ws + OFF_WMAIN);
      const int cp = nt_ * 64; scol = cp < 3072 ? cp : (cp < 6144 ? cp + 1024 : (cp < 7168 ? cp - 3072 : cp)); }
    else if ((j -= T_MAIN) < T_G) { nt_ = j / 32; kt_ = j % 32; src = p.w_in; ld = INC; K = 2048; dst = (u16*)(p.ws + OFF_WG); scol = 9224 + nt_ * 64; }
    else if ((j -= T_G) < T_PA) { nt_ = j / 16; kt_ = j % 16; src = p.w_pa; ld = 2048; K = 1024; dst = (u16*)(p.ws + OFF_WPA); scol = nt_ * 64; }
    else if ((j -= T_PA) < T_PM) { nt_ = j / 16; kt_ = j % 16; src = p.w_pm; ld = 2048; K = 1024; dst = (u16*)(p.ws + OFF_WPM); scol = nt_ * 64; }
    else { j -= T_PM; nt_ = j / 32; kt_ = j % 32; src = p.w_out; ld = 2048; K = 2048; dst = (u16*)(p.ws + OFF_WOUT); scol = nt_ * 64; }
    __syncthreads();
    { const int r = tid >> 4, c4 = (tid & 15) * 4;
      const float* g = src + (size_t)(kt_ * 64 + r) * ld + scol + c4;
      f32x4 v[8];
      UNR for (int q = 0; q < 8; ++q) v[q] = *(const f32x4*)(g + (size_t)q * 32 * ld);
      UNR for (int q = 0; q < 8; ++q) { float* t = fl + (q >> 1) * 4160 + ((q & 1) * 32 + r) * 65 + c4; t[0] = v[q][0]; t[1] = v[q][1]; t[2] = v[q][2]; t[3] = v[q][3]; } }
    __syncthreads();
    { const int nrow = tid >> 3, k8 = tid & 7; const int ncol = (nrow & 32) + perm32(nrow & 31);
      UNR for (int t = 0; t < 4; ++t) {
        float v[8]; UNR for (int jj = 0; jj < 8; ++jj) v[jj] = fl[t * 4160 + (k8 * 8 + jj) * 65 + ncol];
        u32x4 w; w.x = pk_bf16(v[0], v[1]); w.y = pk_bf16(v[2], v[3]); w.z = pk_bf16(v[4], v[5]); w.w = pk_bf16(v[6], v[7]);
        *(u32x4*)(dst + (size_t)(nt_ * 64 + nrow) * K + (kt_ + t) * 64 + k8 * 8) = w; } }
  }
}

DEV void phase_h(const Params& p, char* lds) {
  const int tid = ltid(), wid = tid >> 6, lane = tid & 63;
  float* gsc = (float*)lds; float* sh = gsc + 2048; float* wif = sh + 2048;
  const float* modp = (const float*)(p.ws + OFF_MODP);
  u16* H = (u16*)(p.ws + OFF_H); float* IFG = (float*)(p.ws + OFF_IFG);
  for (int rb = blockIdx.x; rb < NTOK / 64; rb += gridDim.x) {
    const int b = (rb * 64) / SEQ;
    __syncthreads();
    for (int i = tid; i < 2048; i += NTHR) { float s0 = p.b_ada[i], s1 = p.b_ada[2048 + i];
      UNR for (int kp = 0; kp < 8; ++kp) { s0 += modp[(size_t)(kp * 2 + b) * 6144 + i]; s1 += modp[(size_t)(kp * 2 + b) * 6144 + 2048 + i]; }
      gsc[i] = p.norm_gain[i] * (1.0f + s1); sh[i] = s0; }
    if ((rb & 127) == 0) for (int i = tid; i < 2048; i += NTHR) { float s2 = p.b_ada[4096 + i];
      UNR for (int kp = 0; kp < 8; ++kp) s2 += modp[(size_t)(kp * 2 + b) * 6144 + 4096 + i];
      ((float*)(p.ws + OFF_MOD))[b * 6144 + 4096 + i] = s2; }
    for (int i = tid; i < 4096; i += NTHR) { const int k = i >> 1, hf = i & 1; const f32x4 wv4 = *(const f32x4*)(p.w_in + (size_t)k * INC + 9216 + hf * 4);
      UNR for (int e = 0; e < 4; ++e) wif[(hf * 4 + e) * 2048 + k] = wv4[e]; }
    __syncthreads();
    const float* xr0 = p.x + (size_t)(rb * 64 + wid * 8) * DM + lane * 4;
    f32x4 xn[8];
    UNR for (int i = 0; i < 8; ++i) xn[i] = *(const f32x4*)(xr0 + 256 * i);
#pragma unroll 1
    for (int rr = 0; rr < 8; ++rr) {
      const int row = rb * 64 + wid * 8 + rr;
      f32x4 xv[8]; float ss = 0.f;
      UNR for (int i = 0; i < 8; ++i) { xv[i] = xn[i]; ss += xv[i][0] * xv[i][0] + xv[i][1] * xv[i][1] + xv[i][2] * xv[i][2] + xv[i][3] * xv[i][3]; }
      if (rr < 7) { UNR for (int i = 0; i < 8; ++i) xn[i] = *(const f32x4*)(xr0 + (size_t)(rr + 1) * DM + 256 * i); }
      ss = wave_sum(ss);
      const float rstd = rsqrtf(ss * (1.0f / 2048.0f) + 1e-6f);
      float a[8]; UNR for (int j = 0; j < 8; ++j) a[j] = 0.f;
      UNR for (int i = 0; i < 8; ++i) { const int c0 = lane * 4 + 256 * i;
        const f32x4 gv = *(const f32x4*)(gsc + c0), sv = *(const f32x4*)(sh + c0);
        const f32x4 hv = xv[i] * rstd * gv + sv;
        UNR for (int j = 0; j < 8; ++j) { const f32x4 wj = *(const f32x4*)(wif + j * 2048 + c0); a[j] += hv[0] * wj[0] + hv[1] * wj[1] + hv[2] * wj[2] + hv[3] * wj[3]; }
        u32x2 w; w.x = pk_bf16(hv[0], hv[1]); w.y = pk_bf16(hv[2], hv[3]);
        *(u32x2*)(H + (size_t)row * DM + c0) = w;
        asm volatile("" ::: "memory"); }
      UNR for (int j = 0; j < 8; ++j) a[j] = wave_sum(a[j]);
      if (lane < 8) { float v = a[0]; for (int j = 1; j < 8; ++j) v = (lane == j) ? a[j] : v; IFG[(size_t)row * 8 + lane] = v + p.b_gate_if[lane]; }
    }
  }
}

DEV void phase_gemm_main(const Params& p, char* lds) {
  const u16* H = (const u16*)(p.ws + OFF_H); const u16* W = (const u16*)(p.ws + OFF_WMAIN); char* ws = p.ws;
  gemm_stream(H, DM, W, DM, DM, 64, 36, (lchar*)lds, [=](const f32x4 (&acc)[2][2][4][2], int pm, int pn, int wr, int wc, int fr, int fq) {
    const int cb = pn * 256, buf = cb / 3072, cc = cb % 3072;
    u16* O = (u16*)(ws + (buf == 0 ? OFF_P1 : (buf == 1 ? OFF_P2 : OFF_P3)));
    UNR for (int ai = 0; ai < 2; ++ai) UNR for (int m = 0; m < 4; ++m) { u16* rp = O + (size_t)(pm * 256 + ROW_(ai, m)) * 3072 + cc;
      UNR for (int bj = 0; bj < 2; ++bj) { const f32x4 v0 = acc[ai][bj][m][0], v1 = acc[ai][bj][m][1]; u32x4 w;
        w.x = pk_bf16(v0[0], v0[1]); w.y = pk_bf16(v0[2], v0[3]); w.z = pk_bf16(v1[0], v1[1]); w.w = pk_bf16(v1[2], v1[3]);
        *(u32x4*)(rp + COLP_(bj)) = w; } }
  });
}

template <int OFF> DEV u32x2 tr_read(unsigned addr) { u32x2 r; asm volatile("ds_read_b64_tr_b16 %0, %1 offset:%2" : "=&v"(r) : "v"(addr), "i"(OFF) : "memory"); return r; }
#define TR2(c) v0[c] = tr_read<(c) * 32>(vb); v1[c] = tr_read<1088 + (c) * 32>(vb);
constexpr int ABUF = 69632, AVOFF = 34816;
DEV void attn_chunk(const Params& p, char* lds_, int ci) {
  lchar* lds = (lchar*)lds_;
  const int tid = ltid(), wid = __builtin_amdgcn_readfirstlane(tid >> 6), lane = tid & 63, fr = lane & 15, g = lane >> 4;
  const int pat = ci >> 8, rem = ci & 255;
  const int d = pat == 0 ? 1 : (pat == 1 ? 4 : 16), cps = 16 / d;
  const int cpos = rem % cps, stream = rem / cps, r = stream % d, bh = stream / d, b = bh >> 3, h = bh & 7;
  const int n0 = cpos * 4;
  const u16* P1 = (const u16*)(p.ws + OFF_P1) + (size_t)b * SEQ * 3072 + h * 128;
  const int lrow = tid >> 4, lch = tid & 15;
  u32x4 kreg[4], vreg[4];
  __syncthreads();
  const int qi = 16 * wid + fr;
  bf16x8 qn[4];
  { u32x4 kr2[4], vr2[4];
    if (n0 > 0) {
      UNR for (int ps = 0; ps < 4; ++ps) { const int tk = ((n0 - 1) * 128 + lrow + 32 * ps) * d + r; const u16* s = P1 + (size_t)tk * 3072 + lch * 8; kreg[ps] = *(const u32x4*)(s + 1024); vreg[ps] = *(const u32x4*)(s + 2048); }
    } else {
      UNR for (int ps = 0; ps < 4; ++ps) { kreg[ps] = (u32x4){0u, 0u, 0u, 0u}; vreg[ps] = (u32x4){0u, 0u, 0u, 0u}; }
    }
    UNR for (int ps = 0; ps < 4; ++ps) { const int tk = (n0 * 128 + lrow + 32 * ps) * d + r; const u16* s = P1 + (size_t)tk * 3072 + lch * 8; kr2[ps] = *(const u32x4*)(s + 1024); vr2[ps] = *(const u32x4*)(s + 2048); }
    { const u16* qp = P1 + (size_t)((n0 * 128 + qi) * d + r) * 3072 + 8 * g;
      UNR for (int s = 0; s < 4; ++s) qn[s] = *(const bf16x8*)(qp + 32 * s); }
    UNR for (int ps = 0; ps < 4; ++ps) { *(LAS u32x4*)(lds + (lrow + 32 * ps) * 272 + lch * 16) = kreg[ps]; *(LAS u32x4*)(lds + AVOFF + (lrow + 32 * ps) * 272 + lch * 16) = vreg[ps]; }
    UNR for (int ps = 0; ps < 4; ++ps) { *(LAS u32x4*)(lds + ABUF + (lrow + 32 * ps) * 272 + lch * 16) = kr2[ps]; *(LAS u32x4*)(lds + ABUF + AVOFF + (lrow + 32 * ps) * 272 + lch * 16) = vr2[ps]; } }
  __syncthreads();
  const float c1 = 0.08838834764831845f * 1.4426950408889634f, c2 = exp2f(-(float)(h + 1)) * (float)d * 1.4426950408889634f;
#pragma unroll 1
  for (int i = 0; i < 4; ++i) {
    const int nq = n0 + i;
    lchar* prevB = lds + (i & 1) * ABUF; lchar* curB = lds + ((i + 1) & 1) * ABUF;
    const int tq = (nq * 128 + qi) * d + r;
    bf16x8 qf[4];
    UNR for (int s = 0; s < 4; ++s) qf[s] = qn[s];
    if (i < 3) {
      UNR for (int ps = 0; ps < 4; ++ps) { const int tk = ((nq + 1) * 128 + lrow + 32 * ps) * d + r; const u16* s = P1 + (size_t)tk * 3072 + lch * 8; kreg[ps] = *(const u32x4*)(s + 1024); vreg[ps] = *(const u32x4*)(s + 2048); }
      const u16* qp = P1 + (size_t)(((nq + 1) * 128 + qi) * d + r) * 3072 + 8 * g;
      UNR for (int s = 0; s < 4; ++s) qn[s] = *(const bf16x8*)(qp + 32 * s);
    }
    const int u = wid >> 1;
    int gofs[5];
#pragma unroll
    for (int kq = 0; kq < 5; ++kq) { const int ks = u + kq; gofs[kq] = (((ks < 4) ? (i & 1) : ((i + 1) & 1)) * ABUF) + (ks & 3) * 8704; }
    f32x4 sc[5][2];
    { const int koff = (8 * (fr >> 2) + (fr & 3)) * 272 + 16 * g;
      bf16x8 kfa[8], kfb[8];
#pragma unroll
      for (int q = 0; q < 8; ++q) kfa[q] = *(const LAS bf16x8*)(lds + gofs[0] + koff + (q >> 2) * 1088 + 64 * (q & 3));
#pragma unroll
      for (int kq = 0; kq < 5; ++kq) {
        if (kq < 4) {
#pragma unroll
          for (int q = 0; q < 8; ++q) { const bf16x8 v = *(const LAS bf16x8*)(lds + gofs[kq + 1] + koff + (q >> 2) * 1088 + 64 * (q & 3)); if (kq & 1) kfa[q] = v; else kfb[q] = v; }
        }
        SCHED;
#pragma unroll
        for (int t = 0; t < 2; ++t) {
          f32x4 a = {0.f, 0.f, 0.f, 0.f};
#pragma unroll
          for (int s = 0; s < 4; ++s) a = __builtin_amdgcn_mfma_f32_16x16x32_bf16((kq & 1) ? kfb[t * 4 + s] : kfa[t * 4 + s], qf[s], a, 0, 0, 0);
          sc[kq][t] = a;
        }
        SCHED;
      } }
    const int dbl = 16 * (wid & 1) + fr - 8 * g + 128;
    const float b0 = -c2 * (float)dbl;
    float mx = -INFINITY;
#pragma unroll
    for (int kq = 0; kq < 5; ++kq) {
      const bool gval = (nq > 0) || (u + kq >= 4);
#pragma unroll
      for (int t = 0; t < 2; ++t) {
#pragma unroll
        for (int j = 0; j < 4; ++j) {
          const int kk = 32 * kq + 4 * t + j;
          float s = __builtin_fmaf(sc[kq][t][j], c1, __builtin_fmaf(c2, (float)kk, b0));
          bool valid = gval;
          if (kq == 0) valid = valid && (dbl - kk <= 128);
          if (kq == 4) valid = valid && (dbl - kk >= 0);
          s = valid ? s : -INFINITY;
          sc[kq][t][j] = s; mx = fmaxf(mx, s);
        } } }
    mx = fmaxf(mx, __shfl_xor(mx, 16)); mx = fmaxf(mx, __shfl_xor(mx, 32));
    float sum = 0.f;
#pragma unroll
    for (int kq = 0; kq < 5; ++kq) {
#pragma unroll
      for (int t = 0; t < 2; ++t) {
#pragma unroll
        for (int j = 0; j < 4; ++j) { const float e = __builtin_amdgcn_exp2f(sc[kq][t][j] - mx); sc[kq][t][j] = e; sum += e; } } }
    sum += __shfl_xor(sum, 16); sum += __shfl_xor(sum, 32);
    const float inv = __builtin_amdgcn_rcpf(sum);
    f32x4 oc[8];
#pragma unroll
    for (int c = 0; c < 8; ++c) oc[c] = (f32x4){0.f, 0.f, 0.f, 0.f};
    const unsigned vlane = (unsigned)(size_t)lds + AVOFF + (8 * g + (fr >> 2)) * 272 + 8 * (fr & 3);
    u32x2 va0[8], va1[8], vb0[8], vb1[8];
#define TRA(c) va0[c] = tr_read<(c) * 32>(vb); va1[c] = tr_read<1088 + (c) * 32>(vb);
#define TRB(c) vb0[c] = tr_read<(c) * 32>(vb); vb1[c] = tr_read<1088 + (c) * 32>(vb);
    { const unsigned vb = vlane + gofs[0]; TRA(0) TRA(1) TRA(2) TRA(3) TRA(4) TRA(5) TRA(6) TRA(7) }
#pragma unroll
    for (int kq = 0; kq < 5; ++kq) {
      union { bf16x8 v; unsigned u[4]; } pf;
      pf.u[0] = pk_bf16(sc[kq][0][0], sc[kq][0][1]); pf.u[1] = pk_bf16(sc[kq][0][2], sc[kq][0][3]);
      pf.u[2] = pk_bf16(sc[kq][1][0], sc[kq][1][1]); pf.u[3] = pk_bf16(sc[kq][1][2], sc[kq][1][3]);
      asm volatile("s_waitcnt lgkmcnt(0)" ::: "memory"); SCHED;
      if (kq < 4) { const unsigned vb = vlane + gofs[kq + 1];
        if (kq & 1) { TRA(0) TRA(1) TRA(2) TRA(3) TRA(4) TRA(5) TRA(6) TRA(7) } else { TRB(0) TRB(1) TRB(2) TRB(3) TRB(4) TRB(5) TRB(6) TRB(7) } }
#pragma unroll
      for (int c = 0; c < 8; ++c) {
        union { bf16x8 v; unsigned u[4]; } vf;
        if (kq & 1) { vf.u[0] = vb0[c].x; vf.u[1] = vb0[c].y; vf.u[2] = vb1[c].x; vf.u[3] = vb1[c].y; }
        else { vf.u[0] = va0[c].x; vf.u[1] = va0[c].y; vf.u[2] = va1[c].x; vf.u[3] = va1[c].y; }
        oc[c] = __builtin_amdgcn_mfma_f32_16x16x32_bf16(vf.v, pf.v, oc[c], 0, 0, 0);
      }
    }
    { u16* O = (u16*)((char*)p.out + DO_OATT) + ((size_t)pat * NTOK + (size_t)(b * SEQ + tq)) * 1024 + h * 128 + 4 * g;
#pragma unroll
      for (int c = 0; c < 8; ++c) { u32x2 w; w.x = pk_bf16(oc[c][0] * inv, oc[c][1] * inv); w.y = pk_bf16(oc[c][2] * inv, oc[c][3] * inv); *(u32x2*)(O + 16 * c) = w; }
      if (g == 0) ((float*)(p.ws + OFF_LSE))[((size_t)pat * NTOK + (size_t)(b * SEQ + tq)) * 8 + h] = (mx + __builtin_amdgcn_logf(sum)) * 0.6931471805599453f; }
    __syncthreads();
    if (i < 3) {
      UNR for (int ps = 0; ps < 4; ++ps) { *(LAS u32x4*)(prevB + (lrow + 32 * ps) * 272 + lch * 16) = kreg[ps]; *(LAS u32x4*)(prevB + AVOFF + (lrow + 32 * ps) * 272 + lch * 16) = vreg[ps]; }
    }
    __syncthreads();
  }
}

DEV void mprep_item(const Params& p, char* lds, int item) {
  const int tid = ltid();
  const int k = item & 31, h = (item >> 5) & 3, b = item >> 7;
  const int tok0 = b * SEQ + k * 256;
  char* Ts = lds;
  float* sa = (float*)(lds + 135168); float* sb = sa + 256; float* sw = sb + 256; float* red = sw + 256;
  const float* IFG = (const float*)(p.ws + OFF_IFG);
  const u16* P2 = (const u16*)(p.ws + OFF_P2);
  __syncthreads();
  float iv = 0.f, av = 0.f, cv = 0.f;
  if (tid < 256) { const float f = IFG[(size_t)(tok0 + tid) * 8 + 4 + h]; iv = IFG[(size_t)(tok0 + tid) * 8 + h];
    av = fminf(f, 0.f) - log1pf(__expf(-fabsf(f))); sa[tid] = av; }
  __syncthreads();
  for (int off = 1; off < 256; off <<= 1) { float t = 0.f; if (tid < 256 && tid >= off) t = sa[tid - off]; __syncthreads(); if (tid < 256) { av += t; sa[tid] = av; } __syncthreads(); }
  if (tid < 256) { cv = iv - av; sb[tid] = cv; }
  float cm = cv;
  __syncthreads();
  for (int off = 1; off < 256; off <<= 1) { float t = -INFINITY; if (tid < 256 && tid >= off) t = sb[tid - off]; __syncthreads(); if (tid < 256) { cm = fmaxf(cm, t); sb[tid] = cm; } __syncthreads(); }
  const float cmall = sb[255], Aall = sa[255];
  if (tid < 256) { const size_t ix = (size_t)(tok0 + tid) * 4 + h;
    ((float*)(p.ws + OFF_SA))[ix] = av; ((float*)(p.ws + OFF_SC))[ix] = cv; ((float*)(p.ws + OFF_SCM))[ix] = cm;
    sw[tid] = __expf(cv - cmall); }
  if (tid == 0) { ((float*)(p.ws + OFF_IA))[item] = Aall; ((float*)(p.ws + OFF_IG))[item] = Aall + cmall; }
  __syncthreads();
  u16* QC = (u16*)(p.ws + OFF_QC); u16* KC = (u16*)(p.ws + OFF_KC);
  float* nup = red;
  { const int cgp = tid & 31, rg = tid >> 5, e0 = cgp * 8, ch = h * 256 + e0, t0 = rg * 16;
#pragma unroll 1
    for (int pass = 0; pass < 2; ++pass) {
      const int wofs = pass * 1024 + ch;
      float wv[4][8], bv[8];
      UNR for (int e = 0; e < 8; ++e) bv[e] = p.conv_b[wofs + e];
      UNR for (int j = 0; j < 4; ++j) { UNR for (int e = 0; e < 8; ++e) wv[j][e] = p.conv_w[(size_t)j * 2048 + wofs + e]; }
      float ns[8]; UNR for (int e = 0; e < 8; ++e) ns[e] = 0.f;
#pragma unroll 1
      for (int half = 0; half < 2; ++half) {
      u32x4 rows[11];
      UNR for (int i = 0; i < 11; ++i) { const int pos = k * 256 + t0 + half * 8 + i - 3;
        rows[i] = (pos >= 0) ? *(const u32x4*)(P2 + (size_t)(tok0 + t0 + half * 8 + i - 3) * 3072 + pass * 1024 + ch) : (u32x4){0u, 0u, 0u, 0u}; }
      UNR for (int i = 0; i < 8; ++i) {
        float acc8[8]; UNR for (int e = 0; e < 8; ++e) acc8[e] = bv[e];
        UNR for (int j = 0; j < 4; ++j) { const u32x4 rv = rows[i + j]; const unsigned ru[4] = {rv.x, rv.y, rv.z, rv.w};
          UNR for (int e = 0; e < 4; ++e) { acc8[2 * e] += wv[j][2 * e] * bflo(ru[e]); acc8[2 * e + 1] += wv[j][2 * e + 1] * bfhi(ru[e]); } }
        const int t = t0 + half * 8 + i;
        if (pass == 0) {
          UNR for (int e = 0; e < 8; ++e) acc8[e] = siluf_(acc8[e]);
          u32x4 o; o.x = pk_bf16(acc8[0], acc8[1]); o.y = pk_bf16(acc8[2], acc8[3]); o.z = pk_bf16(acc8[4], acc8[5]); o.w = pk_bf16(acc8[6], acc8[7]);
          *(u32x4*)(QC + (size_t)(tok0 + t) * 1024 + ch) = o;
        } else {
          const float w = sw[t]; float kw[8];
          UNR for (int e = 0; e < 8; ++e) { acc8[e] = siluf_(acc8[e]) * 0.0625f; kw[e] = acc8[e] * w; }
          u32x4 o; o.x = pk_bf16(acc8[0], acc8[1]); o.y = pk_bf16(acc8[2], acc8[3]); o.z = pk_bf16(acc8[4], acc8[5]); o.w = pk_bf16(acc8[6], acc8[7]);
          *(u32x4*)(KC + (size_t)(tok0 + t) * 1024 + ch) = o;
          o.x = pk_bf16(kw[0], kw[1]); o.y = pk_bf16(kw[2], kw[3]); o.z = pk_bf16(kw[4], kw[5]); o.w = pk_bf16(kw[6], kw[7]);
          *(u32x4*)(Ts + t * 528 + e0 * 2) = o;
          const unsigned ou[4] = {o.x, o.y, o.z, o.w};
          UNR for (int e = 0; e < 4; ++e) { ns[2 * e] += bflo(ou[e]); ns[2 * e + 1] += bfhi(ou[e]); }
        }
        asm volatile("" ::: "memory");
      }
      }
      if (pass == 1) { *(f32x4*)(nup + rg * 256 + e0) = (f32x4){ns[0], ns[1], ns[2], ns[3]}; *(f32x4*)(nup + rg * 256 + e0 + 4) = (f32x4){ns[4], ns[5], ns[6], ns[7]}; }
    } }
  __syncthreads();
  const int wid = __builtin_amdgcn_readfirstlane(tid >> 6), lane = tid & 63, li = lane & 15, lg = lane >> 4;
  const unsigned trl = (unsigned)(size_t)(lchar*)lds + (8 * lg + (li >> 2)) * 528 + 8 * (li & 3);
  { u16* KWT = (u16*)(p.ws + OFF_KWT) + (size_t)item * 65536;
#pragma unroll 1
    for (int j4 = 0; j4 < 4; ++j4) { u32x2 ra[4], rb[4];
      UNR for (int q = 0; q < 4; ++q) { const int uq = wid * 16 + j4 * 4 + q, eb = (uq & 15) * 16, sb2 = (uq >> 4) * 32; const unsigned ad = trl + sb2 * 528 + eb * 2;
        ra[q] = tr_read<0>(ad); rb[q] = tr_read<4 * 528>(ad); }
      asm volatile("s_waitcnt lgkmcnt(0)" ::: "memory"); SCHED;
      UNR for (int q = 0; q < 4; ++q) { const int uq = wid * 16 + j4 * 4 + q, eb = (uq & 15) * 16, sb2 = (uq >> 4) * 32;
        u32x4 o; o.x = ra[q].x; o.y = ra[q].y; o.z = rb[q].x; o.w = rb[q].y; *(u32x4*)(KWT + (size_t)(eb + li) * 256 + sb2 + 8 * lg) = o; } }
    if (tid < 256) { float s = 0.f; UNR for (int q = 0; q < 16; ++q) s += nup[q * 256 + tid]; ((float*)(p.ws + OFF_NU))[(size_t)item * 256 + tid] = s; } }
  __syncthreads();
  { u32x4 vr[16];
    UNR for (int itr = 0; itr < 16; ++itr) { const int u = tid + NTHR * itr, t = u >> 5, e0 = (u & 31) * 8; vr[itr] = *(const u32x4*)(P2 + (size_t)(tok0 + t) * 3072 + 2048 + h * 256 + e0); }
    UNR for (int itr = 0; itr < 16; ++itr) { const int u = tid + NTHR * itr, t = u >> 5, e0 = (u & 31) * 8; *(u32x4*)(Ts + t * 528 + e0 * 2) = vr[itr]; } }
  __syncthreads();
  { u16* VT = (u16*)((char*)p.out + DO_VT) + (size_t)item * 65536;
#pragma unroll 1
    for (int j4 = 0; j4 < 4; ++j4) { u32x2 ra[4], rb[4];
      UNR for (int q = 0; q < 4; ++q) { const int uq = wid * 16 + j4 * 4 + q, eb = (uq & 15) * 16, sb2 = (uq >> 4) * 32; const unsigned ad = trl + sb2 * 528 + eb * 2;
        ra[q] = tr_read<0>(ad); rb[q] = tr_read<4 * 528>(ad); }
      asm volatile("s_waitcnt lgkmcnt(0)" ::: "memory"); SCHED;
      UNR for (int q = 0; q < 4; ++q) { const int uq = wid * 16 + j4 * 4 + q, eb = (uq & 15) * 16, sb2 = (uq >> 4) * 32;
        u32x4 o; o.x = ra[q].x; o.y = ra[q].y; o.z = rb[q].x; o.w = rb[q].y; *(u32x4*)(VT + (size_t)(eb + li) * 256 + sb2 + 8 * lg) = o; } } }
}


DEV void u_item(const Params& p, char* lds, int item) {
  WLANE; lchar* shm = (lchar*)lds;
  f32x4 acc[2][2][4][2]; acc_zero(acc);
  gemm_kloop(acc, (const u16*)((char*)p.out + DO_VT) + (size_t)item * 65536, 256, (const u16*)(p.ws + OFF_KWT) + (size_t)item * 65536, 256, 256, shm);
  { RELANE; u16* rp = (u16*)(p.ws + OFF_KWT) + (size_t)item * 65536 + (size_t)ROW_(0, 0) * 256 + COLP_(0);
    UNR for (int ai = 0; ai < 2; ++ai) UNR for (int m = 0; m < 4; ++m) { u16* q = rp + (ai * 128 + m * 16) * 256; asm volatile("" : "+v"(q) :: "memory");
      UNR for (int bj = 0; bj < 2; ++bj) { const f32x4 v0 = acc[ai][bj][m][0], v1 = acc[ai][bj][m][1]; u32x4 w;
        w.x = pk_bf16(v0[0], v0[1]); w.y = pk_bf16(v0[2], v0[3]); w.z = pk_bf16(v1[0], v1[1]); w.w = pk_bf16(v1[2], v1[3]); *(u32x4*)(q + bj * 128) = w; } } }
}

DEV void phase_d1(const Params& p, char* lds) {
  const bool attn_first = (blockIdx.x >> 3) & 1;
  if (attn_first) for (int v = blockIdx.x; v < 768; v += gridDim.x) attn_chunk(p, lds, (v & ~255) + ((v & 7) * 32 + ((v & 255) >> 3)));
  for (int item = blockIdx.x; item < 256; item += gridDim.x) { mprep_item(p, lds, item);
    asm volatile("s_waitcnt vmcnt(0)" ::: "memory"); __syncthreads();
    u_item(p, lds, item); }
#if PROBE_DUP == 20
  for (int item = blockIdx.x; item < 256; item += gridDim.x) mprep_item(p, lds, item);
#endif
#if PROBE_DUP == 21
  for (int ci = blockIdx.x; ci < 768; ci += gridDim.x) attn_chunk(p, lds, ci);
#endif
  if (!attn_first) for (int v = blockIdx.x; v < 768; v += gridDim.x) attn_chunk(p, lds, (v & ~255) + ((v & 7) * 32 + ((v & 255) >> 3)));
}

DEV void phase_scan(const Params& p, char* lds) {
  const float* IA = (const float*)(p.ws + OFF_IA); const float* IG = (const float*)(p.ws + OFF_IG);
  const int nthreads = gridDim.x * NTHR;
  for (int gid = blockIdx.x * NTHR + ltid(); gid < 8 * 16384; gid += nthreads) {
    const int bh = gid >> 14, idx = (gid & 16383) * 4;
    f32x4 C = {0.f, 0.f, 0.f, 0.f}; float m = 0.f;
    const u16* Ub = (const u16*)(p.ws + OFF_KWT) + (size_t)(bh * 32) * 65536 + idx;
    u32x2 ua[8], ub[8];
    UNR for (int j = 0; j < 8; ++j) ua[j] = *(const u32x2*)(Ub + (size_t)j * 65536);
#pragma unroll
    for (int kb = 0; kb < 4; ++kb) {
      if (kb < 3) { UNR for (int j = 0; j < 8; ++j) { const u32x2 v = *(const u32x2*)(Ub + (size_t)((kb + 1) * 8 + j) * 65536); if (kb & 1) ua[j] = v; else ub[j] = v; } }
      UNR for (int j = 0; j < 8; ++j) { const int item = bh * 32 + kb * 8 + j;
        u32x2 w; w.x = pk_bf16(C[0], C[1]); w.y = pk_bf16(C[2], C[3]);
        *(u32x2*)((u16*)(p.ws + OFF_CT) + (size_t)item * 65536 + idx) = w;
        if (idx == 0) ((float*)(p.ws + OFF_MK))[item] = m;
        const float A = IA[item], G = IG[item], mn = fmaxf(A + m, G), al = __expf(A + m - mn), be = __expf(G - mn);
        const u32x2 uv = (kb & 1) ? ub[j] : ua[j];
        const f32x4 u = {bflo(uv.x), bfhi(uv.x), bflo(uv.y), bfhi(uv.y)};
        C = C * al + u * be; m = mn; } }
  }
  for (int gid = blockIdx.x * NTHR + ltid(); gid < 2048; gid += nthreads) {
    const int bh = gid >> 8, e = gid & 255; float n = 0.f, m = 0.f;
    for (int k = 0; k < 32; ++k) { const int item = bh * 32 + k;
      ((float*)(p.ws + OFF_NK))[(size_t)item * 256 + e] = n;
      const float A = IA[item], G = IG[item], mn = fmaxf(A + m, G), al = __expf(A + m - mn), be = __expf(G - mn);
      n = n * al + ((const float*)(p.ws + OFF_NU))[(size_t)item * 256 + e] * be; m = mn; }
  }
}

DEV void mout_item(const Params& p, char* lds, int item) {
  WLANE; const int tid = ltid(); lchar* shm = (lchar*)lds;
  const int k = item & 31, h = (item >> 5) & 3, b = item >> 7; (void)k;
  const int tok0 = b * SEQ + (item & 31) * 256;
  float* sMt = (float*)(lds + 131072); float* sWin = sMt + 256; float* sCs = sWin + 256; float* sEm = sCs + 256; float* sQn = sEm + 256;
  float* sRow = sQn + 256;
  float* sR1 = (float*)lds; float* sR2 = sR1 + 1024;
  const u16* QC = (const u16*)(p.ws + OFF_QC) + (size_t)tok0 * 1024 + h * 256;
  const u16* KC = (const u16*)(p.ws + OFF_KC) + (size_t)tok0 * 1024 + h * 256;
  const float mk = ((const float*)(p.ws + OFF_MK))[item];
  __syncthreads();
  if (tid < 256) { const size_t ix = (size_t)(tok0 + tid) * 4 + h;
    const float a = ((const float*)(p.ws + OFF_SA))[ix], c = ((const float*)(p.ws + OFF_SC))[ix], cm = ((const float*)(p.ws + OFF_SCM))[ix];
    const float Mt = fmaxf(mk, cm); sMt[tid] = Mt; sWin[tid] = __expf(mk - Mt); sCs[tid] = c; sEm[tid] = __expf(-(a + Mt)); }
  { const float* NK = (const float*)(p.ws + OFF_NK) + (size_t)item * 256;
    const f32x4 nv = *(const f32x4*)(NK + lane * 4);
#pragma unroll 1
    for (int r8 = 0; r8 < 4; ++r8) { u32x2 qv[8];
      UNR for (int j = 0; j < 8; ++j) qv[j] = *(const u32x2*)(QC + (size_t)(wid * 32 + r8 * 8 + j) * 1024 + lane * 4);
      UNR for (int j = 0; j < 8; ++j) { float s = bflo(qv[j].x) * nv[0] + bfhi(qv[j].x) * nv[1] + bflo(qv[j].y) * nv[2] + bfhi(qv[j].y) * nv[3];
        s = wave_sum(s); if (lane == 0) sQn[wid * 32 + r8 * 8 + j] = s; } } }
  __syncthreads();
  f32x4 acc[2][2][4][2]; acc_zero(acc);
  gemm_kloop(acc, launder(QC), 1024, launder(KC), 1024, 256, shm);
  { RELANE; u16* PB = launder((u16*)(p.ws + OFF_PB) + (size_t)item * 65536);
    UNR for (int ai = 0; ai < 2; ++ai) UNR for (int m = 0; m < 4; ++m) { const int t = ROW_(ai, m); const float Mt = sMt[t]; float rs = 0.f;
      UNR for (int bj = 0; bj < 2; ++bj) { const int s0 = COLP_(bj); float pv[8];
        const f32x4 c0 = *(const f32x4*)(sCs + s0), c1 = *(const f32x4*)(sCs + s0 + 4);
        UNR for (int j = 0; j < 4; ++j) { const float m0 = (s0 + j <= t) ? 1.0f : 0.0f, m1 = (s0 + 4 + j <= t) ? 1.0f : 0.0f;
          pv[j] = m0 * acc[ai][bj][m][0][j] * __expf(fminf(c0[j] - Mt, 0.f)); pv[4 + j] = m1 * acc[ai][bj][m][1][j] * __expf(fminf(c1[j] - Mt, 0.f)); rs += pv[j] + pv[4 + j]; }
        u32x4 w; w.x = pk_bf16(pv[0], pv[1]); w.y = pk_bf16(pv[2], pv[3]); w.z = pk_bf16(pv[4], pv[5]); w.w = pk_bf16(pv[6], pv[7]); *(u32x4*)(PB + (size_t)t * 256 + s0) = w; }
      rs += __shfl_xor(rs, 16); rs += __shfl_xor(rs, 32);
      if (fq == 0) sRow[wc * 256 + t] = rs;
      asm volatile("" ::: "memory"); } }
  asm volatile("s_waitcnt vmcnt(0)" ::: "memory"); __syncthreads();
  acc_zero(acc);
  gemm_kloop(acc, launder(QC), 1024, launder((const u16*)(p.ws + OFF_CT) + (size_t)item * 65536), 256, 256, shm);
  { RELANE;
    UNR for (int ai = 0; ai < 2; ++ai) UNR for (int m = 0; m < 4; ++m) { const float w = sWin[ROW_(ai, m)];
      UNR for (int bj = 0; bj < 2; ++bj) UNR for (int n = 0; n < 2; ++n) acc[ai][bj][m][n] = acc[ai][bj][m][n] * w; } }
  gemm_kloop(acc, launder((const u16*)(p.ws + OFF_PB) + (size_t)item * 65536), 256, launder((const u16*)((char*)p.out + DO_VT) + (size_t)item * 65536), 256, 256, shm);
  { RELANE; const u16* P3 = launder((const u16*)(p.ws + OFF_P3) + (size_t)tok0 * 3072 + 1024 + h * 256);
    UNR for (int ai = 0; ai < 2; ++ai) { u32x4 ov[4][2];
      UNR for (int m = 0; m < 4; ++m) UNR for (int bj = 0; bj < 2; ++bj) ov[m][bj] = *(const u32x4*)(P3 + (size_t)ROW_(ai, m) * 3072 + COLP_(bj));
      UNR for (int m = 0; m < 4; ++m) { const int t = ROW_(ai, m);
        const float den = sRow[t] + sRow[256 + t] + sRow[512 + t] + sRow[768 + t] + sWin[t] * sQn[t];
        const float rden = __builtin_amdgcn_rcpf(fmaxf(fabsf(den), sEm[t])); float s1 = 0.f, s2 = 0.f;
        UNR for (int bj = 0; bj < 2; ++bj) { const u32x4 o4 = ov[m][bj];
          f32x4 v0 = acc[ai][bj][m][0] * rden, v1 = acc[ai][bj][m][1] * rden;
          v0[0] *= sigmoidf_(bflo(o4.x)); v0[1] *= sigmoidf_(bfhi(o4.x)); v0[2] *= sigmoidf_(bflo(o4.y)); v0[3] *= sigmoidf_(bfhi(o4.y));
          v1[0] *= sigmoidf_(bflo(o4.z)); v1[1] *= sigmoidf_(bfhi(o4.z)); v1[2] *= sigmoidf_(bflo(o4.w)); v1[3] *= sigmoidf_(bfhi(o4.w));
          acc[ai][bj][m][0] = v0; acc[ai][bj][m][1] = v1;
          s1 += v0[0] + v0[1] + v0[2] + v0[3] + v1[0] + v1[1] + v1[2] + v1[3];
          s2 += v0[0] * v0[0] + v0[1] * v0[1] + v0[2] * v0[2] + v0[3] * v0[3] + v1[0] * v1[0] + v1[1] * v1[1] + v1[2] * v1[2] + v1[3] * v1[3]; }
        s1 += __shfl_xor(s1, 16); s1 += __shfl_xor(s1, 32); s2 += __shfl_xor(s2, 16); s2 += __shfl_xor(s2, 32);
        if (fq == 0) { sR1[wc * 256 + t] = s1; sR2[wc * 256 + t] = s2; } }
      asm volatile("" : "+v"(acc[ai][0][0][0]), "+v"(acc[ai][0][1][0]), "+v"(acc[ai][0][2][0]), "+v"(acc[ai][0][3][0]) :: "memory"); } }
  __syncthreads();
  { RELANE; const u16* P3z = launder((const u16*)(p.ws + OFF_P3) + (size_t)tok0 * 3072 + 2048 + h * 256);
    u16* AM = launder((u16*)(p.ws + OFF_AM) + (size_t)tok0 * 1024 + h * 256); const float* gnp = launder(p.mgain + h * 256);
    f32x4 gn[2][2]; UNR for (int bj = 0; bj < 2; ++bj) { gn[bj][0] = *(const f32x4*)(gnp + COLP_(bj)); gn[bj][1] = *(const f32x4*)(gnp + COLP_(bj) + 4); }
    UNR for (int ai = 0; ai < 2; ++ai) { u32x4 zv[4][2];
      UNR for (int m = 0; m < 4; ++m) UNR for (int bj = 0; bj < 2; ++bj) zv[m][bj] = *(const u32x4*)(P3z + (size_t)ROW_(ai, m) * 3072 + COLP_(bj));
      UNR for (int m = 0; m < 4; ++m) { const int t = ROW_(ai, m);
        const float s1 = sR1[t] + sR1[256 + t] + sR1[512 + t] + sR1[768 + t], s2 = sR2[t] + sR2[256 + t] + sR2[512 + t] + sR2[768 + t];
        const float mu = s1 * (1.0f / 256.0f), var = fmaxf(s2 * (1.0f / 256.0f) - mu * mu, 0.f), rstd = rsqrtf(var + 1e-6f);
        UNR for (int bj = 0; bj < 2; ++bj) { const u32x4 z4 = zv[m][bj]; const f32x4 g0 = gn[bj][0], g1 = gn[bj][1]; const f32x4 v0 = acc[ai][bj][m][0], v1 = acc[ai][bj][m][1];
          const float y0 = (v0[0] - mu) * rstd * g0[0] * siluf_(bflo(z4.x)), y1 = (v0[1] - mu) * rstd * g0[1] * siluf_(bfhi(z4.x));
          const float y2 = (v0[2] - mu) * rstd * g0[2] * siluf_(bflo(z4.y)), y3 = (v0[3] - mu) * rstd * g0[3] * siluf_(bfhi(z4.y));
          const float y4 = (v1[0] - mu) * rstd * g1[0] * siluf_(bflo(z4.z)), y5 = (v1[1] - mu) * rstd * g1[1] * siluf_(bfhi(z4.z));
          const float y6 = (v1[2] - mu) * rstd * g1[2] * siluf_(bflo(z4.w)), y7 = (v1[3] - mu) * rstd * g1[3] * siluf_(bfhi(z4.w));
          u32x4 w; w.x = pk_bf16(y0, y1); w.y = pk_bf16(y2, y3); w.z = pk_bf16(y4, y5); w.w = pk_bf16(y6, y7); *(u32x4*)(AM + (size_t)t * 1024 + COLP_(bj)) = w; } }
      asm volatile("" ::: "memory"); } }
}

DEV void amerge_unit(const u16* __restrict__ OA, const float* __restrict__ LSE, const u16* __restrict__ P3, u16* __restrict__ AA, int u,
                     u32x4& a, u32x4& b, u32x4& c, u32x4& z, float& l0, float& l1, float& l2) {
  const int tok = u >> 7, c0 = (u & 127) * 8, h = c0 >> 7;
  l0 = LSE[(size_t)tok * 8 + h]; l1 = LSE[((size_t)NTOK + tok) * 8 + h]; l2 = LSE[((size_t)2 * NTOK + tok) * 8 + h];
  a = *(const u32x4*)(OA + (size_t)tok * 1024 + c0); b = *(const u32x4*)(OA + ((size_t)NTOK + tok) * 1024 + c0); c = *(const u32x4*)(OA + ((size_t)2 * NTOK + tok) * 1024 + c0);
  z = *(const u32x4*)(P3 + (size_t)tok * 3072 + c0);
}
DEV void amerge_fin(u16* __restrict__ AA, int u, const u32x4& a, const u32x4& b, const u32x4& c, const u32x4& z, float l0, float l1, float l2) {
  const int tok = u >> 7, c0 = (u & 127) * 8;
  const float mx = fmaxf(l0, fmaxf(l1, l2)); float w0 = __expf(l0 - mx), w1 = __expf(l1 - mx), w2 = __expf(l2 - mx);
  const float inv = __builtin_amdgcn_rcpf(w0 + w1 + w2); w0 *= inv; w1 *= inv; w2 *= inv;
  const unsigned au[4] = {a.x, a.y, a.z, a.w}, bu[4] = {b.x, b.y, b.z, b.w}, cu[4] = {c.x, c.y, c.z, c.w}, zu[4] = {z.x, z.y, z.z, z.w};
  unsigned o[4];
  UNR for (int e = 0; e < 4; ++e) {
    const float lo = (w0 * bflo(au[e]) + w1 * bflo(bu[e]) + w2 * bflo(cu[e])) * siluf_(bflo(zu[e]));
    const float hi = (w0 * bfhi(au[e]) + w1 * bfhi(bu[e]) + w2 * bfhi(cu[e])) * siluf_(bfhi(zu[e]));
    o[e] = pk_bf16(lo, hi); }
  u32x4 w; w.x = o[0]; w.y = o[1]; w.z = o[2]; w.w = o[3];
  *(u32x4*)(AA + (size_t)tok * 1024 + c0) = w;
}
DEV void phase_amerge(const Params& p) {
  const u16* OA = (const u16*)((char*)p.out + DO_OATT); const float* LSE = (const float*)(p.ws + OFF_LSE);
  const u16* P3 = (const u16*)(p.ws + OFF_P3); u16* AA = (u16*)(p.ws + OFF_AA);
  const int nthreads = gridDim.x * NTHR, N = NTOK * 128;
#pragma unroll 1
  for (int u = blockIdx.x * NTHR + ltid(); u < N; u += 4 * nthreads) {
    u32x4 a[4], b[4], c[4], z[4]; float l0[4], l1[4], l2[4];
    UNR for (int q = 0; q < 4; ++q) { const int uq = u + q * nthreads; if (uq < N) amerge_unit(OA, LSE, P3, AA, uq, a[q], b[q], c[q], z[q], l0[q], l1[q], l2[q]); }
    UNR for (int q = 0; q < 4; ++q) { const int uq = u + q * nthreads; if (uq < N) amerge_fin(AA, uq, a[q], b[q], c[q], z[q], l0[q], l1[q], l2[q]); }
  }
}
DEV void phase_d4(const Params& p, char* lds) {
  const bool merge_first = (blockIdx.x >> 3) & 1;
  if (merge_first) phase_amerge(p);
  for (int item = blockIdx.x; item < 256; item += gridDim.x) mout_item(p, lds, item);
#if PROBE_DUP == 22
  for (int item = blockIdx.x; item < 256; item += gridDim.x) mout_item(p, lds, item);
#endif
  if (!merge_first) phase_amerge(p);
#if PROBE_DUP == 23
  phase_amerge(p);
#endif
}

DEV size_t gate_off(int pm, int pg, int wid, int ai, int m, int bj, int lane) {
  return ((((((size_t)(pm * 16 + pg) * 8 + wid) * 2 + ai) * 4 + m) * 2 + bj) * 64 + lane) * 8;
}
DEV void phase_gemm_gates(const Params& p, char* lds) {
  const u16* H = (const u16*)(p.ws + OFF_H); const u16* W = (const u16*)(p.ws + OFF_WG); u16* P4 = (u16*)(p.ws + OFF_P4);
  gemm_stream(H, DM, W, DM, DM, 64, 16, (lchar*)lds, [=](const f32x4 (&acc)[2][2][4][2], int pm, int pn, int wr, int wc, int fr, int fq) {
    const int wid_ = wr * 4 + wc, lane_ = fq * 16 + fr;
    UNR for (int ai = 0; ai < 2; ++ai) UNR for (int m = 0; m < 4; ++m) {
      UNR for (int bj = 0; bj < 2; ++bj) { const f32x4 v0 = acc[ai][bj][m][0], v1 = acc[ai][bj][m][1]; u32x4 w;
        w.x = pk_bf16(sigmoidf_(v0[0]), sigmoidf_(v0[1])); w.y = pk_bf16(sigmoidf_(v0[2]), sigmoidf_(v0[3]));
        w.z = pk_bf16(sigmoidf_(v1[0]), sigmoidf_(v1[1])); w.w = pk_bf16(sigmoidf_(v1[2]), sigmoidf_(v1[3]));
        *(u32x4*)(P4 + gate_off(pm, pn, wid_, ai, m, bj, lane_)) = w; } }
  });
}

DEV void phase_gemm_merge(const Params& p, char* lds) {
  const u16* AA = (const u16*)(p.ws + OFF_AA); const u16* AM = (const u16*)(p.ws + OFF_AM);
  const u16* WA = (const u16*)(p.ws + OFF_WPA); const u16* WM = (const u16*)(p.ws + OFF_WPM);
  const u16* P4 = (const u16*)(p.ws + OFF_P4); u16* MG = (u16*)(p.ws + OFF_MG);
  gemm_stream2(AA, AM, 1024, WA, WM, 1024, 1024, 64, 8, (lchar*)lds, [=](f32x4 (&acc)[2][2][4][2], int pm, int pn, int seg, int wr, int wc) {
    RELANE; const u16* P4a = launder(P4); const int wid_ = wr * 4 + wc, lane_ = fq * 16 + fr;
    if (seg == 0) {
      UNR for (int ai = 0; ai < 2; ++ai) UNR for (int m = 0; m < 4; ++m) {
        UNR for (int bj = 0; bj < 2; ++bj) { const u32x4 ga = *(const u32x4*)(P4a + gate_off(pm, pn, wid_, ai, m, bj, lane_)), gb = *(const u32x4*)(P4a + gate_off(pm, 8 + pn, wid_, ai, m, bj, lane_));
          f32x4 v0 = acc[ai][bj][m][0], v1 = acc[ai][bj][m][1];
          v0[0] *= bflo(ga.x) * __builtin_amdgcn_rcpf(bflo(gb.x)); v0[1] *= bfhi(ga.x) * __builtin_amdgcn_rcpf(bfhi(gb.x)); v0[2] *= bflo(ga.y) * __builtin_amdgcn_rcpf(bflo(gb.y)); v0[3] *= bfhi(ga.y) * __builtin_amdgcn_rcpf(bfhi(gb.y));
          v1[0] *= bflo(ga.z) * __builtin_amdgcn_rcpf(bflo(gb.z)); v1[1] *= bfhi(ga.z) * __builtin_amdgcn_rcpf(bfhi(gb.z)); v1[2] *= bflo(ga.w) * __builtin_amdgcn_rcpf(bflo(gb.w)); v1[3] *= bfhi(ga.w) * __builtin_amdgcn_rcpf(bfhi(gb.w));
          acc[ai][bj][m][0] = v0; acc[ai][bj][m][1] = v1; }
        asm volatile("" : "+v"(acc[ai][0][m][0]), "+v"(acc[ai][0][m][1]), "+v"(acc[ai][1][m][0]), "+v"(acc[ai][1][m][1]) :: "memory"); }
    } else {
      UNR for (int ai = 0; ai < 2; ++ai) UNR for (int m = 0; m < 4; ++m) { const size_t ro = (size_t)(pm * 256 + ROW_(ai, m));
        UNR for (int bj = 0; bj < 2; ++bj) { const u32x4 gb = *(const u32x4*)(P4a + gate_off(pm, 8 + pn, wid_, ai, m, bj, lane_));
          const f32x4 v0 = acc[ai][bj][m][0], v1 = acc[ai][bj][m][1]; u32x4 w;
          w.x = pk_bf16(v0[0] * bflo(gb.x), v0[1] * bfhi(gb.x)); w.y = pk_bf16(v0[2] * bflo(gb.y), v0[3] * bfhi(gb.y));
          w.z = pk_bf16(v1[0] * bflo(gb.z), v1[1] * bfhi(gb.z)); w.w = pk_bf16(v1[2] * bflo(gb.w), v1[3] * bfhi(gb.w));
          *(u32x4*)(MG + ro * DM + pn * 256 + COLP_(bj)) = w; }
        asm volatile("" ::: "memory"); }
    }
  });
}

DEV void phase_gm(const Params& p, char* lds) {
  const u16* H = (const u16*)(p.ws + OFF_H); const u16* WG = (const u16*)(p.ws + OFF_WG);
  const u16* AA = (const u16*)(p.ws + OFF_AA); const u16* AM = (const u16*)(p.ws + OFF_AM);
  const u16* WA = (const u16*)(p.ws + OFF_WPA); const u16* WM = (const u16*)(p.ws + OFF_WPM);
  u16* P4 = (u16*)(p.ws + OFF_P4); u16* MG = (u16*)(p.ws + OFF_MG);
  gemm_stream_gm(H, WG, AA, AM, WA, WM, 64, 8, (lchar*)lds, [=](f32x4 (&acc)[2][2][4][2], int pm, int pn, int q, int wr, int wc) {
    RELANE; u16* P4a = launder(P4); const int wid_ = wr * 4 + wc, lane_ = fq * 16 + fr;
    if (q < 2) {
      UNR for (int ai = 0; ai < 2; ++ai) UNR for (int m = 0; m < 4; ++m) {
        UNR for (int bj = 0; bj < 2; ++bj) { const f32x4 v0 = acc[ai][bj][m][0], v1 = acc[ai][bj][m][1]; u32x4 w;
          w.x = pk_bf16(sigmoidf_(v0[0]), sigmoidf_(v0[1])); w.y = pk_bf16(sigmoidf_(v0[2]), sigmoidf_(v0[3]));
          w.z = pk_bf16(sigmoidf_(v1[0]), sigmoidf_(v1[1])); w.w = pk_bf16(sigmoidf_(v1[2]), sigmoidf_(v1[3]));
          *(u32x4*)(P4a + gate_off(pm, q * 8 + pn, wid_, ai, m, bj, lane_)) = w; } }
    } else if (q == 2) {
      UNR for (int ai = 0; ai < 2; ++ai) UNR for (int m = 0; m < 4; ++m) {
        UNR for (int bj = 0; bj < 2; ++bj) { const u32x4 ga = *(const u32x4*)(P4a + gate_off(pm, pn, wid_, ai, m, bj, lane_)), gb = *(const u32x4*)(P4a + gate_off(pm, 8 + pn, wid_, ai, m, bj, lane_));
          f32x4 v0 = acc[ai][bj][m][0], v1 = acc[ai][bj][m][1];
          v0[0] *= bflo(ga.x) * __builtin_amdgcn_rcpf(bflo(gb.x)); v0[1] *= bfhi(ga.x) * __builtin_amdgcn_rcpf(bfhi(gb.x)); v0[2] *= bflo(ga.y) * __builtin_amdgcn_rcpf(bflo(gb.y)); v0[3] *= bfhi(ga.y) * __builtin_amdgcn_rcpf(bfhi(gb.y));
          v1[0] *= bflo(ga.z) * __builtin_amdgcn_rcpf(bflo(gb.z)); v1[1] *= bfhi(ga.z) * __builtin_amdgcn_rcpf(bfhi(gb.z)); v1[2] *= bflo(ga.w) * __builtin_amdgcn_rcpf(bflo(gb.w)); v1[3] *= bfhi(ga.w) * __builtin_amdgcn_rcpf(bfhi(gb.w));
          acc[ai][bj][m][0] = v0; acc[ai][bj][m][1] = v1; }
        asm volatile("" : "+v"(acc[ai][0][m][0]), "+v"(acc[ai][0][m][1]), "+v"(acc[ai][1][m][0]), "+v"(acc[ai][1][m][1]) :: "memory"); }
    } else {
      UNR for (int ai = 0; ai < 2; ++ai) UNR for (int m = 0; m < 4; ++m) { const size_t ro = (size_t)(pm * 256 + ROW_(ai, m));
        UNR for (int bj = 0; bj < 2; ++bj) { const u32x4 gb = *(const u32x4*)(P4a + gate_off(pm, 8 + pn, wid_, ai, m, bj, lane_));
          const f32x4 v0 = acc[ai][bj][m][0], v1 = acc[ai][bj][m][1]; u32x4 w;
          w.x = pk_bf16(v0[0] * bflo(gb.x), v0[1] * bfhi(gb.x)); w.y = pk_bf16(v0[2] * bflo(gb.y), v0[3] * bfhi(gb.y));
          w.z = pk_bf16(v1[0] * bflo(gb.z), v1[1] * bfhi(gb.z)); w.w = pk_bf16(v1[2] * bflo(gb.w), v1[3] * bfhi(gb.w));
          *(u32x4*)(MG + ro * DM + pn * 256 + COLP_(bj)) = w; }
        asm volatile("" ::: "memory"); }
    }
  });
}

DEV void phase_gemm_out(const Params& p, char* lds) {
  const u16* MG = (const u16*)(p.ws + OFF_MG); const u16* WO = (const u16*)(p.ws + OFF_WOUT);
  const float* mod = (const float*)(p.ws + OFF_MOD); u16* DL = (u16*)(p.ws + OFF_DL);
  gemm_stream(MG, DM, WO, DM, DM, 64, 8, (lchar*)lds, [=](const f32x4 (&acc)[2][2][4][2], int pm, int pn, int wr, int wc, int fr, int fq) {
    const int b = (pm * 256) / SEQ;
    UNR for (int bj = 0; bj < 2; ++bj) { const int c0 = pn * 256 + COLP_(bj);
      const f32x4 g0 = *(const f32x4*)(mod + b * 6144 + 4096 + c0), g1 = *(const f32x4*)(mod + b * 6144 + 4096 + c0 + 4);
      UNR for (int ai = 0; ai < 2; ++ai) UNR for (int m = 0; m < 4; ++m) { const size_t ro = (size_t)(pm * 256 + ROW_(ai, m)) * DM + c0;
        const f32x4 v0 = g0 * acc[ai][bj][m][0], v1 = g1 * acc[ai][bj][m][1]; u32x4 w;
        w.x = pk_bf16(v0[0], v0[1]); w.y = pk_bf16(v0[2], v0[3]); w.z = pk_bf16(v1[0], v1[1]); w.w = pk_bf16(v1[2], v1[3]);
        *(u32x4*)(DL + ro) = w; } }
  });
}

DEV void phase_final(const Params& p) {
  const int wid = ltid() >> 6, lane = ltid() & 63;
  const u16* DL = (const u16*)(p.ws + OFF_DL);
#pragma unroll 1
  for (int row = (blockIdx.x * 8 + wid) * 2; row < NTOK; row += gridDim.x * 16) {
    const size_t ro = (size_t)row * DM + lane * 4;
    f32x4 xv[8], yv[8]; u32x2 dx[8], dy[8]; float ss = 0.f, st = 0.f;
    UNR for (int i = 0; i < 8; ++i) { xv[i] = *(const f32x4*)(p.x + ro + 256 * i); yv[i] = *(const f32x4*)(p.x + ro + DM + 256 * i);
      dx[i] = *(const u32x2*)(DL + ro + 256 * i); dy[i] = *(const u32x2*)(DL + ro + DM + 256 * i); }
    UNR for (int i = 0; i < 8; ++i) {
      xv[i][0] += bflo(dx[i].x); xv[i][1] += bfhi(dx[i].x); xv[i][2] += bflo(dx[i].y); xv[i][3] += bfhi(dx[i].y);
      yv[i][0] += bflo(dy[i].x); yv[i][1] += bfhi(dy[i].x); yv[i][2] += bflo(dy[i].y); yv[i][3] += bfhi(dy[i].y);
      ss += xv[i][0] * xv[i][0] + xv[i][1] * xv[i][1] + xv[i][2] * xv[i][2] + xv[i][3] * xv[i][3];
      st += yv[i][0] * yv[i][0] + yv[i][1] * yv[i][1] + yv[i][2] * yv[i][2] + yv[i][3] * yv[i][3]; }
    ss = wave_sum(ss); st = wave_sum(st);
    const float r0 = rsqrtf(ss * (1.0f / 2048.0f) + 1e-6f), r1 = rsqrtf(st * (1.0f / 2048.0f) + 1e-6f);
    UNR for (int i = 0; i < 8; ++i) { const f32x4 g = *(const f32x4*)(p.fgain + lane * 4 + 256 * i); *(f32x4*)(p.out + ro + 256 * i) = xv[i] * r0 * g; *(f32x4*)(p.out + ro + DM + 256 * i) = yv[i] * r1 * g; }
  }
}


#define XB_TMO      128
#define XB_XCNT(j)  (256  + 64 * (j))
#define XB_XSUB(j)  (1280 + 64 * (j))
#define XB_XGEN(j)  (2304 + 64 * (j))
#define XB_TOP      3328
#define XB_TOPGEN   3392
#define XCD_BAR_WORDS 3456
#define XB_SPIN_CAP (1u << 20)
DEV unsigned xb_ld(unsigned* p)              { return __hip_atomic_load(p, __ATOMIC_RELAXED, __HIP_MEMORY_SCOPE_AGENT); }
DEV unsigned xb_add(unsigned* p, unsigned v) { return __hip_atomic_fetch_add(p, v, __ATOMIC_RELAXED, __HIP_MEMORY_SCOPE_AGENT); }
DEV unsigned xb_xcc_id() { return (unsigned)__builtin_amdgcn_s_getreg((3 << 11) | 20) & 0xFu; }
#define XB_SPIN(cond, bar) do { unsigned _sp = 0; while (cond) { __builtin_amdgcn_s_sleep(1); \
    if ((++_sp & 255u) == 0u) { if (xb_ld(&(bar)[XB_TMO])) break; if (_sp > XB_SPIN_CAP) { atomicAdd(&(bar)[XB_TMO], 1u); break; } } } } while (0)
struct XcdBarrier { unsigned* bar; unsigned x; volatile LAS unsigned* st; };
DEV XcdBarrier xcd_barrier_post(unsigned* bar, volatile LAS unsigned* st) {
  XcdBarrier b; b.bar = bar; b.x = xb_xcc_id(); b.st = st;
  if (threadIdx_x_raw() == 0) (void)xb_add(&bar[XB_XCNT(b.x)], 1u);
  return b;
}
DEV void xcd_barrier_complete(unsigned* bar, unsigned x, unsigned& nloc, unsigned& nx) {
  const unsigned G = gridDim.x;
  unsigned sum, cnt, mine, sp = 0u;
  for (;;) {
    sum = 0u; cnt = 0u; mine = 0u;
#pragma unroll
    for (unsigned j = 0; j < 16; ++j) { const unsigned c = xb_ld(&bar[XB_XCNT(j)]); sum += c; cnt += (c > 0u) ? 1u : 0u; mine = (j == x) ? c : mine; }
    if (sum == G) break;
    __builtin_amdgcn_s_sleep(1);
    if ((++sp & 255u) == 0u) { if (xb_ld(&bar[XB_TMO])) break; if (sp > XB_SPIN_CAP) { atomicAdd(&bar[XB_TMO], 1u); break; } }
  }
  nloc = mine > 0u ? mine : 1u; nx = cnt > 0u ? cnt : 1u;
}
DEV void xcd_barrier(const XcdBarrier& b) {
  asm volatile("s_waitcnt vmcnt(0)" ::: "memory");
  __syncthreads();
  if (threadIdx_x_raw() == 0) {
    unsigned* bar = b.bar;
    __builtin_amdgcn_s_waitcnt(0);
    unsigned nloc = b.st[0], nx = b.st[1];
    if (nloc == 0u) { xcd_barrier_complete(bar, b.x, nloc, nx); b.st[0] = nloc; b.st[1] = nx; }
    const unsigned old = xb_add(&bar[XB_XSUB(b.x)], 1u);
    const unsigned gen = old / nloc;
    if (old + 1u == (gen + 1u) * nloc) {
      __builtin_amdgcn_fence(__ATOMIC_RELEASE, "agent");
      asm volatile("s_waitcnt vmcnt(0)" ::: "memory");
      const unsigned og = xb_add(&bar[XB_TOP], 1u);
      const unsigned tg = og / nx;
      if (og + 1u == (tg + 1u) * nx) xb_add(&bar[XB_TOPGEN], 1u);
      else XB_SPIN(xb_ld(&bar[XB_TOPGEN]) == tg, bar);
      __builtin_amdgcn_fence(__ATOMIC_ACQUIRE, "agent");
      xb_add(&bar[XB_XGEN(b.x)], 1u);
      asm volatile("s_waitcnt vmcnt(0)" ::: "memory");
    } else {
      XB_SPIN(xb_ld(&bar[XB_XGEN(b.x)]) == gen, bar);
      __builtin_amdgcn_fence(__ATOMIC_ACQUIRE, "agent");
      asm volatile("s_waitcnt vmcnt(0)" ::: "memory");
    }
  }
  __syncthreads();
}

constexpr int NPHASE = 11;
#ifndef ONE_LAUNCH
#define ONE_LAUNCH 1
#endif
#if ONE_LAUNCH
__global__ void __launch_bounds__(NTHR, 2) mega(Params p) {
  extern __shared__ __attribute__((aligned(16))) char lds[];
  cg::grid_group grid = cg::this_grid();
  volatile LAS unsigned* st = (volatile LAS unsigned*)((lchar*)lds + OFF_LDS_ST);
  if (threadIdx_x_raw() == 0) { st[0] = 0u; st[1] = 0u; }
  __syncthreads();
  const XcdBarrier xb = xcd_barrier_post((unsigned*)(p.ws + OFF_BAR), st);
  if (p.ws == nullptr) grid.sync();
  phase_prep(p, lds); xcd_barrier(xb);
  phase_h(p, lds); xcd_barrier(xb);
#if PROBE_DUP == 8
  phase_prep(p, lds); xcd_barrier(xb);
#endif
#if PROBE_DUP == 9
  phase_h(p, lds); xcd_barrier(xb);
#endif
#if PROBE_DUP == 4
  phase_prep(p, lds); xcd_barrier(xb); phase_h(p, lds); xcd_barrier(xb);
#endif
  phase_gemm_main(p, lds); xcd_barrier(xb);
#if PROBE_DUP == 1
  phase_gemm_main(p, lds); xcd_barrier(xb);
#endif
  phase_d1(p, lds); xcd_barrier(xb);
#if PROBE_DUP == 2
  phase_d1(p, lds); xcd_barrier(xb);
#endif
  phase_scan(p, lds); xcd_barrier(xb);
  phase_d4(p, lds); xcd_barrier(xb);
#if PROBE_DUP == 11
  phase_scan(p, lds); xcd_barrier(xb);
#endif
#if PROBE_DUP == 12
  phase_d4(p, lds); xcd_barrier(xb);
#endif
#if PROBE_DUP == 3
  phase_scan(p, lds); xcd_barrier(xb); phase_d4(p, lds); xcd_barrier(xb);
#endif
#if USE_GM
  phase_gm(p, lds); xcd_barrier(xb);
#else
  phase_gemm_gates(p, lds); xcd_barrier(xb);
#if PROBE_DUP == 5
  phase_gemm_gates(p, lds); xcd_barrier(xb);
#endif
  phase_gemm_merge(p, lds); xcd_barrier(xb);
#endif
#if PROBE_DUP == 6
  phase_gemm_merge(p, lds); xcd_barrier(xb);
#endif
  phase_gemm_out(p, lds); xcd_barrier(xb);
#if PROBE_DUP == 7
  phase_gemm_out(p, lds); xcd_barrier(xb);
#endif
  phase_final(p);
#if PROBE_DUP == 24
  xcd_barrier(xb); phase_final(p);
#endif
}
#define MEGA_FN mega
static void setattr_all() {}
#else
template <int PH> __global__ void __launch_bounds__(NTHR, 2) phk(Params p) {
  extern __shared__ __attribute__((aligned(16))) char lds[];
  if (PH == 0) phase_prep(p, lds);
  if (PH == 1) phase_h(p, lds);
  if (PH == 2) phase_gemm_main(p, lds);
  if (PH == 3) phase_d1(p, lds);
  if (PH == 4) { }
  if (PH == 5) phase_scan(p, lds);
  if (PH == 6) phase_d4(p, lds);
  if (PH == 7) phase_gemm_gates(p, lds);
  if (PH == 8) phase_gemm_merge(p, lds);
  if (PH == 9) phase_gemm_out(p, lds);
  if (PH == 10) phase_final(p);
}
#define MEGA_FN phk<2>
template <int PH> static void setattr_ph() { (void)hipFuncSetAttribute((const void*)phk<PH>, hipFuncAttributeMaxDynamicSharedMemorySize, LDS_BYTES); }
static void setattr_all() { setattr_ph<0>(); setattr_ph<1>(); setattr_ph<2>(); setattr_ph<3>(); setattr_ph<4>(); setattr_ph<5>(); setattr_ph<6>(); setattr_ph<7>(); setattr_ph<8>(); setattr_ph<9>(); setattr_ph<10>(); }
template <int PH> static void launch_ph(const Params& p, int grid, hipStream_t stream) {
  phk<PH><<<dim3(grid), dim3(NTHR), LDS_BYTES, stream>>>(p);
}
#endif

extern "C" void kernel_launch(void* const* d_in, const int* in_sizes, int n_in, void* d_out, int out_size, void* d_ws, size_t ws_size, hipStream_t stream) {
  static int grid = 0;
  if (!grid) {
    if (ws_size < WS_NEED || out_size != NTOK * DM || n_in != 14) { fprintf(stderr, "kernel_launch: unexpected sizes (ws %zu need %zu)\n", ws_size, (size_t)WS_NEED); grid = -1; return; }
    int dev = 0, cus = 0, per_cu = 0;
    (void)hipGetDevice(&dev); (void)hipDeviceGetAttribute(&cus, hipDeviceAttributeMultiprocessorCount, dev);
    (void)hipFuncSetAttribute((const void*)MEGA_FN, hipFuncAttributeMaxDynamicSharedMemorySize, LDS_BYTES); setattr_all();
    (void)hipOccupancyMaxActiveBlocksPerMultiprocessor(&per_cu, (const void*)MEGA_FN, NTHR, LDS_BYTES);
    if (per_cu < 1) { fprintf(stderr, "kernel_launch: occupancy query says 0 blocks per CU\n"); grid = -1; return; }
    grid = cus;
  }
  if (grid < 0) return;
  Params p{};
  p.x = (const float*)d_in[0]; p.c = (const float*)d_in[1]; p.norm_gain = (const float*)d_in[2]; p.w_ada = (const float*)d_in[3]; p.b_ada = (const float*)d_in[4];
  p.w_in = (const float*)d_in[5]; p.b_gate_if = (const float*)d_in[6]; p.conv_w = (const float*)d_in[7]; p.conv_b = (const float*)d_in[8]; p.mgain = (const float*)d_in[9];
  p.w_pa = (const float*)d_in[10]; p.w_pm = (const float*)d_in[11]; p.w_out = (const float*)d_in[12]; p.fgain = (const float*)d_in[13];
  p.out = (float*)d_out; p.ws = (char*)d_ws;
#if ONE_LAUNCH
  (void)hipMemsetAsync((char*)d_ws + OFF_BAR, 0, XCD_BAR_WORDS * 4, stream);
  void* args[] = {&p};
  hipError_t e = hipLaunchCooperativeKernel((const void*)mega, dim3(grid), dim3(NTHR), args, LDS_BYTES, stream);
  if (e != hipSuccess) fprintf(stderr, "cooperative launch failed: %s\n", hipGetErrorString(e));
#else
  launch_ph<0>(p, grid, stream); launch_ph<1>(p, grid, stream); launch_ph<2>(p, grid, stream); launch_ph<3>(p, grid, stream);
  launch_ph<4>(p, grid, stream); launch_ph<5>(p, grid, stream); launch_ph<6>(p, grid, stream); launch_ph<7>(p, grid, stream);
  launch_ph<8>(p, grid, stream); launch_ph<9>(p, grid, stream); launch_ph<10>(p, grid, stream);
#endif
}
```

```cpp
#include <hip/hip_runtime.h>
#include <hip/hip_cooperative_groups.h>
#include <cstdio>
#include <cstdint>
namespace cg = cooperative_groups;

typedef unsigned short u16;
typedef short bf16x8 __attribute__((ext_vector_type(8)));
typedef float f32x4 __attribute__((ext_vector_type(4)));
typedef unsigned u32x4 __attribute__((ext_vector_type(4)));
typedef unsigned u32x2 __attribute__((ext_vector_type(2)));

#define PROBE_DUP 0
#define USE_GM 1
#define DEV __device__ __forceinline__
__device__ __forceinline__ int threadIdx_x_raw() { return (int)threadIdx.x; }
DEV int ltid() { int t = threadIdx_x_raw(); asm volatile("" : "+v"(t)); return t; }
#define UNR _Pragma("unroll")
#define RELANE int l_ = ltid() & 63; asm volatile("" : "+v"(l_)); const int fr = l_ & 15, fq = l_ >> 4; (void)fr; (void)fq
template <class T> __device__ __forceinline__ T* launder(T* p) { asm volatile("" : "+s"(p)); return p; }

constexpr int NTOK = 16384, DM = 2048, SEQ = 8192, INC = 13320;
constexpr int NTHR = 512;
constexpr int LDS_BYTES = 159744;
constexpr size_t MBy = 1ull << 20;
constexpr size_t OFF_MODP = 576 * 1024;
constexpr size_t OFF_MOD = 0, OFF_BAR = 49152, OFF_IFG = 64 * 1024, OFF_LSE = 1 * MBy;
constexpr int OFF_LDS_ST = 159488;
constexpr size_t OFF_SA = 2 * MBy + 512 * 1024, OFF_SC = OFF_SA + 256 * 1024, OFF_SCM = OFF_SC + 256 * 1024;
constexpr size_t OFF_IA = 3 * MBy + 256 * 1024, OFF_IG = OFF_IA + 4096, OFF_MK = OFF_IG + 4096;
constexpr size_t OFF_NU = 3 * MBy + 512 * 1024, OFF_NK = OFF_NU + 256 * 1024;
constexpr size_t OFF_WPA = 4 * MBy, OFF_WPM = 8 * MBy, OFF_WOUT = 12 * MBy, OFF_WG = 20 * MBy, OFF_WMAIN = 36 * MBy;
constexpr size_t OFF_H = 72 * MBy, OFF_P3 = 136 * MBy, OFF_P1 = 232 * MBy, OFF_P2 = 328 * MBy;
constexpr size_t OFF_QC = 424 * MBy, OFF_KC = 456 * MBy, WS_NEED = 488 * MBy;
constexpr size_t OFF_KWT = OFF_WMAIN;
constexpr size_t OFF_U = 232 * MBy, OFF_CT = 296 * MBy, OFF_PB = 328 * MBy, OFF_AA = 360 * MBy, OFF_AM = 392 * MBy;
constexpr size_t OFF_P4 = 232 * MBy;
constexpr size_t OFF_MG = 424 * MBy;
constexpr size_t OFF_DL = 360 * MBy;
constexpr size_t DO_OATT = 0, DO_VT = 96 * MBy;

struct Params {
  const float *x, *c, *norm_gain, *w_ada, *b_ada, *w_in, *b_gate_if, *conv_w, *conv_b, *mgain, *w_pa, *w_pm, *w_out, *fgain;
  float* out; char* ws;
};

DEV float bf2f(u16 v) { return __uint_as_float(((unsigned)v) << 16); }
DEV float bflo(unsigned u) { return __uint_as_float(u << 16); }
DEV float bfhi(unsigned u) { return __uint_as_float(u & 0xffff0000u); }
typedef float f32x2_ __attribute__((ext_vector_type(2)));
typedef __bf16 bf16x2_ __attribute__((ext_vector_type(2)));
DEV unsigned pk_bf16(float lo, float hi) { f32x2_ v = {lo, hi}; bf16x2_ b = __builtin_convertvector(v, bf16x2_); return __builtin_bit_cast(unsigned, b); }
DEV float sigmoidf_(float v) { return __builtin_amdgcn_rcpf(1.0f + __expf(-v)); }
DEV float siluf_(float v) { return v * __builtin_amdgcn_rcpf(1.0f + __expf(-v)); }
DEV float wave_sum(float v) {
  v += __int_as_float(__builtin_amdgcn_update_dpp(0, __float_as_int(v), 0xB1, 0xf, 0xf, true));
  v += __int_as_float(__builtin_amdgcn_update_dpp(0, __float_as_int(v), 0x4E, 0xf, 0xf, true));
  v += __int_as_float(__builtin_amdgcn_update_dpp(0, __float_as_int(v), 0x141, 0xf, 0xf, true));
  v += __int_as_float(__builtin_amdgcn_update_dpp(0, __float_as_int(v), 0x140, 0xf, 0xf, true));
  return __int_as_float(__builtin_amdgcn_readlane(__float_as_int(v), 0)) + __int_as_float(__builtin_amdgcn_readlane(__float_as_int(v), 16)) +
         __int_as_float(__builtin_amdgcn_readlane(__float_as_int(v), 32)) + __int_as_float(__builtin_amdgcn_readlane(__float_as_int(v), 48));
}
DEV int perm32(int rho) { const int n = rho >> 4, i = rho & 15; return 8 * (i >> 2) + 4 * n + (i & 3); }

constexpr int BK = 64, HALF = 128, HT = HALF * BK;
DEV int lds_byte(int r, int c) { int st = (r >> 4) * 2 + (c >> 5), rr = r & 15, cc = c & 31, ob = rr * 64 + cc * 2; return st * 1024 + (ob ^ (((ob >> 9) & 1) << 5)); }
DEV void stage_rc(int b, int& R, int& C) { int st = b / 1024, sb = b % 1024, swz = sb ^ (((sb >> 9) & 1) << 5); R = (st >> 1) * 16 + swz / 64; C = (st & 1) * 32 + (swz % 64) / 2; }

#define LAS __attribute__((address_space(3)))
typedef LAS char lchar;
constexpr int HTB = HT * 2;
#define SA_(b, h) (((b) * 2 + (h)) * HTB)
#define SB_(b, h) ((4 + (b) * 2 + (h)) * HTB)
#define STAGE(bufoff, gbase, voff) do { _Pragma("unroll") for (int _i = 0; _i < 2; ++_i) \
    __builtin_amdgcn_global_load_lds((const unsigned*)((const char*)(gbase) + (voff)[_i]), (LAS unsigned*)(lds + (bufoff) + ldsw + _i * 8192), 16, 0, 0); } while (0)
#define LDA(dst, b, h) do { _Pragma("unroll") for (int m = 0; m < 4; ++m) _Pragma("unroll") for (int k = 0; k < 2; ++k) dst[m][k] = *(const LAS bf16x8*)(lds + SA_(b, h) + aoff + m * 2048 + k * 1024); } while (0)
#define LDB(dst, b, h) do { _Pragma("unroll") for (int n = 0; n < 2; ++n) _Pragma("unroll") for (int k = 0; k < 2; ++k) dst[n][k] = *(const LAS bf16x8*)(lds + SB_(b, h) + boff + n * 2048 + k * 1024); } while (0)
#define MMA(ai, bj, At, Bx) do { __builtin_amdgcn_s_setprio(1); _Pragma("unroll") for (int m = 0; m < 4; ++m) _Pragma("unroll") for (int n = 0; n < 2; ++n) _Pragma("unroll") for (int k = 0; k < 2; ++k) \
      acc[ai][bj][m][n] = __builtin_amdgcn_mfma_f32_16x16x32_bf16(Bx[n][k], At[m][k], acc[ai][bj][m][n], 0, 0, 0); \
    __builtin_amdgcn_s_setprio(0); } while (0)
#define WAIT_V(n) asm volatile("s_waitcnt vmcnt(" #n ")" ::: "memory")
#define WAIT_L(n) asm volatile("s_waitcnt lgkmcnt(" #n ")" ::: "memory")
#define BAR __builtin_amdgcn_s_barrier()
#define SCHED __builtin_amdgcn_sched_barrier(0)

DEV void gemm_kloop(f32x4 (&acc)[2][2][4][2], const u16* A, int lda, const u16* Bt, int ldb, int K, lchar* lds) {
  const int tid = ltid(), wid = __builtin_amdgcn_readfirstlane(tid >> 6), lane = tid & 63, wr = wid >> 2, wc = wid & 3, fr = lane & 15, fq = lane >> 4;
  unsigned voffA[2], voffB[2];
#pragma unroll
  for (int i = 0; i < 2; ++i) { int R, C; stage_rc(tid * 16 + i * 8192, R, C); const int Rb = (R & ~31) + perm32(R & 31); voffA[i] = (unsigned)(R * lda + C) * 2u; voffB[i] = (unsigned)(Rb * ldb + C) * 2u; }
  const size_t kstep = (size_t)(BK * 2), hA = (size_t)HALF * lda * 2, hB = (size_t)HALF * ldb * 2;
  const unsigned ldsw = (unsigned)wid * 1024u;
  const int aoff = lds_byte(wr * 64 + fr, fq * 8), boff = lds_byte(wc * 32 + fr, fq * 8);
  const char* cA = (const char*)A; const char* cB = (const char*)Bt;
  bf16x8 At[4][2], B0[2][2], B1[2][2];
  const int nt = K / BK;
  STAGE(SB_(0, 0), cB, voffB); STAGE(SA_(0, 0), cA, voffA); STAGE(SB_(0, 1), cB + hB, voffB); STAGE(SA_(0, 1), cA + hA, voffA);
  if (wr == 1) BAR;
  WAIT_V(4); BAR;
  STAGE(SB_(1, 0), cB + kstep, voffB); STAGE(SA_(1, 0), cA + kstep, voffA); STAGE(SB_(1, 1), cB + hB + kstep, voffB);
  WAIT_V(6); BAR;
  for (int t = 0; t < nt - 2; t += 2) {
    const char* a1 = cA + (size_t)(t + 1) * kstep; const char* a2 = a1 + kstep; const char* a3 = a2 + kstep;
    const char* b2 = cB + (size_t)(t + 2) * kstep; const char* b3 = b2 + kstep;
    LDB(B0, 0, 0); SCHED; LDA(At, 0, 0); STAGE(SA_(1, 1), a1 + hA, voffA);
    WAIT_L(8); BAR; WAIT_L(0); MMA(0, 0, At, B0); BAR; SCHED;
    LDB(B1, 0, 1); STAGE(SB_(0, 0), b2, voffB);
    BAR; WAIT_L(0); MMA(0, 1, At, B1); BAR;
    LDA(At, 0, 1); STAGE(SA_(0, 0), a2, voffA);
    BAR; WAIT_L(0); MMA(1, 0, At, B0); BAR; SCHED;
    STAGE(SB_(0, 1), b2 + hB, voffB);
    WAIT_V(6); BAR; MMA(1, 1, At, B1); BAR;
    LDB(B0, 1, 0); SCHED; LDA(At, 1, 0); STAGE(SA_(0, 1), a2 + hA, voffA);
    WAIT_L(8); BAR; WAIT_L(0); MMA(0, 0, At, B0); BAR; SCHED;
    LDB(B1, 1, 1); STAGE(SB_(1, 0), b3, voffB);
    BAR; WAIT_L(0); MMA(0, 1, At, B1); BAR;
    LDA(At, 1, 1); STAGE(SA_(1, 0), a3, voffA);
    BAR; WAIT_L(0); MMA(1, 0, At, B0); BAR; SCHED;
    STAGE(SB_(1, 1), b3 + hB, voffB);
    WAIT_V(6); BAR; MMA(1, 1, At, B1); BAR;
  }
  { LDB(B0, 0, 0); LDA(At, 0, 0); STAGE(SA_(1, 1), cA + (size_t)(nt - 1) * kstep + hA, voffA);
    BAR; WAIT_L(0); MMA(0, 0, At, B0); BAR;
    LDB(B1, 0, 1); BAR; WAIT_L(0); MMA(0, 1, At, B1); BAR;
    LDA(At, 0, 1); WAIT_V(4); BAR; WAIT_L(0); MMA(1, 0, At, B0); MMA(1, 1, At, B1); BAR; }
  { LDB(B0, 1, 0); LDA(At, 1, 0); WAIT_V(2); BAR; WAIT_L(0); MMA(0, 0, At, B0); BAR;
    LDB(B1, 1, 1); WAIT_V(0); BAR; WAIT_L(0); MMA(0, 1, At, B1); BAR;
    LDA(At, 1, 1); BAR; WAIT_L(0); MMA(1, 0, At, B0); MMA(1, 1, At, B1); BAR; }
  if (wr == 0) BAR;
}

DEV void acc_zero(f32x4 (&acc)[2][2][4][2]) {
  _Pragma("unroll") for (int a = 0; a < 2; ++a) _Pragma("unroll") for (int b = 0; b < 2; ++b) _Pragma("unroll") for (int m = 0; m < 4; ++m) _Pragma("unroll") for (int n = 0; n < 2; ++n) acc[a][b][m][n] = (f32x4){0.f, 0.f, 0.f, 0.f};
}
DEV bool tile_next(int i, int nM, int nN, int& pm, int& pn) {
  const int nwg = nM * nN; const long L = (long)i * gridDim.x + blockIdx.x; if (L >= nwg) return false;
  int wgid = (int)L; { const int q = nwg / 8, r = nwg % 8, xcd = wgid % 8, off = wgid / 8; wgid = (xcd < r ? xcd * (q + 1) : r * (q + 1) + (xcd - r) * q) + off; }
  const int nig = 8 * nN, gid = wgid / nig, fm = gid * 8, gsz = (nM - fm) < 8 ? (nM - fm) : 8;
  pm = fm + ((wgid % nig) % gsz); pn = (wgid % nig) / gsz; return true;
}
template <class Epi>
DEV void gemm_stream(const u16* A, int lda, const u16* Bt, int ldb, int K, int nM, int nN, lchar* lds, Epi&& epi) {
  const int tid = ltid(), wid = __builtin_amdgcn_readfirstlane(tid >> 6), lane = tid & 63, wr = wid >> 2, wc = wid & 3, fr = lane & 15, fq = lane >> 4;
  int pm, pn, npm, npn, ui = 0;
  if (!tile_next(0, nM, nN, pm, pn)) return;
  unsigned voffA[2], voffB[2];
#pragma unroll
  for (int i = 0; i < 2; ++i) { int R, C; stage_rc(tid * 16 + i * 8192, R, C); voffA[i] = (unsigned)(R * lda + C) * 2u; voffB[i] = (unsigned)(R * ldb + C) * 2u; }
  const size_t kstep = (size_t)(BK * 2), hA = (size_t)HALF * lda * 2, hB = (size_t)HALF * ldb * 2, tA = 2 * hA, tB = 2 * hB;
  const unsigned ldsw = (unsigned)wid * 1024u;
  const int aoff = lds_byte(wr * 64 + fr, fq * 8), boff = lds_byte(wc * 32 + fr, fq * 8);
  const int nt = K / BK;
  f32x4 acc[2][2][4][2]; acc_zero(acc);
  bf16x8 At[4][2], B0[2][2], B1[2][2];
  const char* cA = (const char*)A + (size_t)pm * tA; const char* cB = (const char*)Bt + (size_t)pn * tB;
  STAGE(SB_(0, 0), cB, voffB); STAGE(SB_(0, 1), cB + hB, voffB); STAGE(SA_(0, 0), cA, voffA); STAGE(SA_(0, 1), cA + hA, voffA);
  if (wr == 1) BAR;
  WAIT_V(2); BAR;
  STAGE(SB_(1, 0), cB + kstep, voffB); STAGE(SA_(1, 0), cA + kstep, voffA); STAGE(SB_(1, 1), cB + hB + kstep, voffB);
  WAIT_V(6); BAR;
  for (;;) {
    const bool has_next = tile_next(ui + 1, nM, nN, npm, npn);
    const char* nA = has_next ? (const char*)A + (size_t)npm * tA : cA; const char* nB = has_next ? (const char*)Bt + (size_t)npn * tB : cB;
    for (int t = 0; t < nt; t += 2) {
      const bool last = (t == nt - 2);
      const char* a1 = cA + (size_t)(t + 1) * kstep;
      const char* a2 = last ? nA : cA + (size_t)(t + 2) * kstep; const char* b2 = last ? nB : cB + (size_t)(t + 2) * kstep;
      const char* a3 = a2 + kstep; const char* b3 = b2 + kstep;
      LDB(B0, 0, 0); LDB(B1, 0, 1); SCHED; LDA(At, 0, 0); STAGE(SA_(1, 1), a1 + hA, voffA);
      WAIT_V(8); WAIT_L(0); BAR; MMA(0, 0, At, B0); MMA(0, 1, At, B1); BAR; SCHED;
      LDA(At, 0, 1); STAGE(SB_(0, 0), b2, voffB); STAGE(SB_(0, 1), b2 + hB, voffB); STAGE(SA_(0, 0), a2, voffA);
      WAIT_V(8); WAIT_L(0); BAR; MMA(1, 0, At, B0); MMA(1, 1, At, B1); BAR; SCHED;
      LDB(B0, 1, 0); LDB(B1, 1, 1); SCHED; LDA(At, 1, 0); STAGE(SA_(0, 1), a2 + hA, voffA);
      WAIT_V(8); WAIT_L(0); BAR; MMA(0, 0, At, B0); MMA(0, 1, At, B1); BAR; SCHED;
      LDA(At, 1, 1); STAGE(SB_(1, 0), b3, voffB); STAGE(SB_(1, 1), b3 + hB, voffB); STAGE(SA_(1, 0), a3, voffA);
      WAIT_V(8); WAIT_L(0); BAR; MMA(1, 0, At, B0); MMA(1, 1, At, B1); BAR; SCHED;
    }
    if (wr == 0) BAR;
    epi(acc, pm, pn, wr, wc, fr, fq);
    if (!has_next) break;
    acc_zero(acc);
    pm = npm; pn = npn; cA = nA; cB = nB; ++ui;
    if (wr == 1) BAR;
  }
  WAIT_V(0);
  BAR;
}

template <class Epi>
DEV void gemm_stream2(const u16* A0, const u16* A1, int lda, const u16* B0p, const u16* B1p, int ldb, int K, int nM, int nN, lchar* lds, Epi&& epi) {
  const int tid = ltid(), wid = __builtin_amdgcn_readfirstlane(tid >> 6), lane = tid & 63, wr = wid >> 2, wc = wid & 3, fr = lane & 15, fq = lane >> 4;
  int pm, pn, npm, npn, ui = 0;
  if (!tile_next(0, nM, nN, pm, pn)) return;
  unsigned voffA[2], voffB[2];
#pragma unroll
  for (int i = 0; i < 2; ++i) { int R, C; stage_rc(tid * 16 + i * 8192, R, C); voffA[i] = (unsigned)(R * lda + C) * 2u; voffB[i] = (unsigned)(R * ldb + C) * 2u; }
  const size_t kstep = (size_t)(BK * 2), hA = (size_t)HALF * lda * 2, hB = (size_t)HALF * ldb * 2, tA = 2 * hA, tB = 2 * hB;
  const unsigned ldsw = (unsigned)wid * 1024u;
  const int aoff = lds_byte(wr * 64 + fr, fq * 8), boff = lds_byte(wc * 32 + fr, fq * 8);
  const int nt = K / BK;
  f32x4 acc[2][2][4][2]; acc_zero(acc);
  bf16x8 At[4][2], B0[2][2], B1[2][2];
  const char* cA = (const char*)A0 + (size_t)pm * tA; const char* cB = (const char*)B0p + (size_t)pn * tB;
  STAGE(SB_(0, 0), cB, voffB); STAGE(SB_(0, 1), cB + hB, voffB); STAGE(SA_(0, 0), cA, voffA); STAGE(SA_(0, 1), cA + hA, voffA);
  if (wr == 1) BAR;
  WAIT_V(2); BAR;
  STAGE(SB_(1, 0), cB + kstep, voffB); STAGE(SA_(1, 0), cA + kstep, voffA); STAGE(SB_(1, 1), cB + hB + kstep, voffB);
  WAIT_V(6); BAR;
  for (;;) {
    const int seg = ui & 1;
    bool has_next = true; npm = pm; npn = pn;
    if (seg) has_next = tile_next((ui >> 1) + 1, nM, nN, npm, npn);
    const char* nA = has_next ? (const char*)(seg ? A0 : A1) + (size_t)npm * tA : cA; const char* nB = has_next ? (const char*)(seg ? B0p : B1p) + (size_t)npn * tB : cB;
    for (int t = 0; t < nt; t += 2) {
      const bool last = (t == nt - 2);
      const char* a1 = cA + (size_t)(t + 1) * kstep;
      const char* a2 = last ? nA : cA + (size_t)(t + 2) * kstep; const char* b2 = last ? nB : cB + (size_t)(t + 2) * kstep;
      const char* a3 = a2 + kstep; const char* b3 = b2 + kstep;
      LDB(B0, 0, 0); LDB(B1, 0, 1); SCHED; LDA(At, 0, 0); STAGE(SA_(1, 1), a1 + hA, voffA);
      WAIT_V(8); WAIT_L(0); BAR; MMA(0, 0, At, B0); MMA(0, 1, At, B1); BAR; SCHED;
      LDA(At, 0, 1); STAGE(SB_(0, 0), b2, voffB); STAGE(SB_(0, 1), b2 + hB, voffB); STAGE(SA_(0, 0), a2, voffA);
      WAIT_V(8); WAIT_L(0); BAR; MMA(1, 0, At, B0); MMA(1, 1, At, B1); BAR; SCHED;
      LDB(B0, 1, 0); LDB(B1, 1, 1); SCHED; LDA(At, 1, 0); STAGE(SA_(0, 1), a2 + hA, voffA);
      WAIT_V(8); WAIT_L(0); BAR; MMA(0, 0, At, B0); MMA(0, 1, At, B1); BAR; SCHED;
      LDA(At, 1, 1); STAGE(SB_(1, 0), b3, voffB); STAGE(SB_(1, 1), b3 + hB, voffB); STAGE(SA_(1, 0), a3, voffA);
      WAIT_V(8); WAIT_L(0); BAR; MMA(1, 0, At, B0); MMA(1, 1, At, B1); BAR; SCHED;
    }
    if (wr == 0) BAR;
    epi(acc, pm, pn, seg, wr, wc);
    if (!has_next) break;
    if (seg) acc_zero(acc);
    pm = npm; pn = npn; cA = nA; cB = nB; ++ui;
    if (wr == 1) BAR;
  }
  WAIT_V(0);
  BAR;
}

#define STAGE2(bufoff, gbase, lg) do { \
    __builtin_amdgcn_global_load_lds((const unsigned*)((const char*)(gbase) + ((lg) ? vL0 : vS0)), (LAS unsigned*)(lds + (bufoff) + ldsw), 16, 0, 0); \
    __builtin_amdgcn_global_load_lds((const unsigned*)((const char*)(gbase) + ((lg) ? vL1 : vS1)), (LAS unsigned*)(lds + (bufoff) + ldsw + 8192), 16, 0, 0); } while (0)
template <class Epi>
DEV void gemm_stream_gm(const u16* H, const u16* WG, const u16* AA, const u16* AM, const u16* WA, const u16* WM, int nM, int nN, lchar* lds, Epi&& epi) {
  const int tid = ltid(), wid = __builtin_amdgcn_readfirstlane(tid >> 6), lane = tid & 63, wr = wid >> 2, wc = wid & 3, fr = lane & 15, fq = lane >> 4;
  int pm, pn, npm, npn, ui = 0;
  if (!tile_next(0, nM, nN, pm, pn)) return;
  unsigned vL0, vL1, vS0, vS1;
  { int R, C; stage_rc(tid * 16, R, C); vL0 = (unsigned)(R * 2048 + C) * 2u; vS0 = (unsigned)(R * 1024 + C) * 2u;
    stage_rc(tid * 16 + 8192, R, C); vL1 = (unsigned)(R * 2048 + C) * 2u; vS1 = (unsigned)(R * 1024 + C) * 2u; }
  const size_t kstep = (size_t)(BK * 2), hL = (size_t)HALF * 2048 * 2, hS = (size_t)HALF * 1024 * 2;
  const unsigned ldsw = (unsigned)wid * 1024u;
  const int aoff = lds_byte(wr * 64 + fr, fq * 8), boff = lds_byte(wc * 32 + fr, fq * 8);
  f32x4 acc[2][2][4][2]; acc_zero(acc);
  bf16x8 At[4][2], B0[2][2], B1[2][2];
#define GM_A(q, tpm) ((q) < 2 ? (const char*)H + (size_t)(tpm) * 256 * 2048 * 2 : (const char*)((q) == 2 ? AA : AM) + (size_t)(tpm) * 256 * 1024 * 2)
#define GM_B(q, tpn) ((q) < 2 ? (const char*)WG + ((size_t)(q) * 2048 + (size_t)(tpn) * 256) * 2048 * 2 : (const char*)((q) == 2 ? WA : WM) + (size_t)(tpn) * 256 * 1024 * 2)
  const char* cA = GM_A(0, pm); const char* cB = GM_B(0, pn);
  STAGE2(SB_(0, 0), cB, true); STAGE2(SB_(0, 1), cB + hL, true); STAGE2(SA_(0, 0), cA, true); STAGE2(SA_(0, 1), cA + hL, true);
  if (wr == 1) BAR;
  WAIT_V(2); BAR;
  STAGE2(SB_(1, 0), cB + kstep, true); STAGE2(SA_(1, 0), cA + kstep, true); STAGE2(SB_(1, 1), cB + hL + kstep, true);
  WAIT_V(6); BAR;
  bool has_next = true;
#define GM_UNIT(Q, NA, NB) do { \
    const char* nA = (NA); const char* nB = (NB); \
    constexpr bool cl = (Q) < 2, nl = (((Q) + 1) & 3) < 2; constexpr int nt = cl ? 32 : 16; \
    const size_t ch = cl ? hL : hS; \
    for (int t = 0; t < nt; t += 2) { \
      const bool last = (t == nt - 2); \
      const char* a1 = cA + (size_t)(t + 1) * kstep; \
      const char* a2 = last ? nA : cA + (size_t)(t + 2) * kstep; const char* b2 = last ? nB : cB + (size_t)(t + 2) * kstep; \
      const char* a3 = a2 + kstep; const char* b3 = b2 + kstep; \
      const bool wl = last ? nl : cl; const size_t h2 = wl ? hL : hS; \
      LDB(B0, 0, 0); LDB(B1, 0, 1); SCHED; LDA(At, 0, 0); STAGE2(SA_(1, 1), a1 + ch, cl); \
      WAIT_V(8); WAIT_L(0); BAR; MMA(0, 0, At, B0); MMA(0, 1, At, B1); BAR; SCHED; \
      LDA(At, 0, 1); STAGE2(SB_(0, 0), b2, wl); STAGE2(SB_(0, 1), b2 + h2, wl); STAGE2(SA_(0, 0), a2, wl); \
      WAIT_V(8); WAIT_L(0); BAR; MMA(1, 0, At, B0); MMA(1, 1, At, B1); BAR; SCHED; \
      LDB(B0, 1, 0); LDB(B1, 1, 1); SCHED; LDA(At, 1, 0); STAGE2(SA_(0, 1), a2 + h2, wl); \
      WAIT_V(8); WAIT_L(0); BAR; MMA(0, 0, At, B0); MMA(0, 1, At, B1); BAR; SCHED; \
      LDA(At, 1, 1); STAGE2(SB_(1, 0), b3, wl); STAGE2(SB_(1, 1), b3 + h2, wl); STAGE2(SA_(1, 0), a3, wl); \
      WAIT_V(8); WAIT_L(0); BAR; MMA(1, 0, At, B0); MMA(1, 1, At, B1); BAR; SCHED; \
    } \
    if (wr == 0) BAR; \
    epi(acc, pm, pn, (Q), wr, wc); \
    cA = nA; cB = nB; } while (0)
  for (;;) {
    GM_UNIT(0, GM_A(1, pm), GM_B(1, pn)); acc_zero(acc); if (wr == 1) BAR;
    GM_UNIT(1, GM_A(2, pm), GM_B(2, pn)); acc_zero(acc); if (wr == 1) BAR;
    GM_UNIT(2, GM_A(3, pm), GM_B(3, pn)); if (wr == 1) BAR;
    has_next = tile_next(ui + 1, nM, nN, npm, npn);
    GM_UNIT(3, has_next ? GM_A(0, npm) : cA, has_next ? GM_B(0, npn) : cB);
    if (!has_next) break;
    acc_zero(acc); pm = npm; pn = npn; ++ui;
    if (wr == 1) BAR;
  }
  WAIT_V(0);
  BAR;
#undef GM_UNIT
#undef GM_A
#undef GM_B
}

#define ROW_(ai, m) (128 * (ai) + 64 * wr + 16 * (m) + fr)
#define COLP_(bj) (128 * (bj) + 32 * wc + 8 * fq)
#define COLN_(bj, n) (128 * (bj) + 32 * wc + 16 * (n) + 4 * fq)
#define WLANE const int wid = __builtin_amdgcn_readfirstlane(ltid() >> 6), lane = ltid() & 63, wr = wid >> 2, wc = wid & 3, fr = lane & 15, fq = lane >> 4; (void)wid; (void)lane; (void)wr; (void)wc; (void)fr; (void)fq

DEV void phase_prep(const Params& p, char* lds) {
  const int tid = ltid(), wid = tid >> 6, lane = tid & 63;
  float* fl = (float*)lds;
  for (int job = blockIdx.x; job < 192; job += gridDim.x) {
    const int cgp = job % 24, kp = job / 24;
    __syncthreads();
    fl[tid] = p.c[(tid >> 8) * 2048 + kp * 256 + (tid & 255)];
    __syncthreads();
    f32x4 a0 = {0.f, 0.f, 0.f, 0.f}, a1 = {0.f, 0.f, 0.f, 0.f};
    const float* wp = p.w_ada + (size_t)(kp * 256 + wid) * 6144 + cgp * 256 + lane * 4;
#pragma unroll 8
    for (int it = 0; it < 32; ++it) { const f32x4 w = __builtin_nontemporal_load((const f32x4*)(wp + (size_t)it * 8 * 6144)); const int kk = it * 8 + wid; a0 += w * fl[kk]; a1 += w * fl[256 + kk]; }
    float* red = fl + 512;
    *(f32x4*)(red + (wid * 2 + 0) * 256 + lane * 4) = a0; *(f32x4*)(red + (wid * 2 + 1) * 256 + lane * 4) = a1;
    __syncthreads();
    { const int bb = tid >> 8, cc = tid & 255; float s = 0.f;
      UNR for (int w = 0; w < 8; ++w) s += red[(w * 2 + bb) * 256 + cc];
      ((float*)(p.ws + OFF_MODP))[(size_t)(kp * 2 + bb) * 6144 + cgp * 256 + cc] = s; }
  }
  constexpr int T_MAIN = 144 * 32, T_G = 64 * 32, T_PA = 32 * 16, T_PM = 32 * 16, T_OUT = 32 * 32;
  constexpr int T_ALL = T_MAIN + T_G + T_PA + T_PM + T_OUT;
  for (int jg = blockIdx.x; jg < T_ALL / 4; jg += gridDim.x) {
    const float* src; int ld, K, nt_, kt_, scol; u16* dst; int j = jg * 4;
    if (j < T_MAIN) { nt_ = j / 32; kt_ = j % 32; src = p.w_in; ld = INC; K = 2048; dst = (u16*)(p.ws + OFF_WMAIN);
      const int cp = nt_ * 64; scol = cp < 3072 ? cp : (cp < 6144 ? cp + 1024 : (cp < 7168 ? cp - 3072 : cp)); }
    else if ((j -= T_MAIN) < T_G) { nt_ = j / 32; kt_ = j % 32; src = p.w_in; ld = INC; K = 2048; dst = (u16*)(p.ws + OFF_WG); scol = 9224 + nt_ * 64; }
    else if ((j -= T_G) < T_PA) { nt_ = j / 16; kt_ = j % 16; src = p.w_pa; ld = 2048; K = 1024; dst = (u16*)(p.ws + OFF_WPA); scol = nt_ * 64; }
    else if ((j -= T_PA) < T_PM) { nt_ = j / 16; kt_ = j % 16; src = p.w_pm; ld = 2048; K = 1024; dst = (u16*)(p.ws + OFF_WPM); scol = nt_ * 64; }
    else { j -= T_PM; nt_ = j / 32; kt_ = j % 32; src = p.w_out; ld = 2048; K = 2048; dst = (u16*)(p.ws + OFF_WOUT); scol = nt_ * 64; }
    __syncthreads();
    { const int r = tid >> 4, c4 = (tid & 15) * 4;
      const float* g = src + (size_t)(kt_ * 64 + r) * ld + scol + c4;
      f32x4 v[8];
      UNR for (int q = 0; q < 8; ++q) v[q] = __builtin_nontemporal_load((const f32x4*)(g + (size_t)q * 32 * ld));
      UNR for (int q = 0; q < 8; ++q) { float* t = fl + (q >> 1) * 4160 + ((q & 1) * 32 + r) * 65 + c4; t[0] = v[q][0]; t[1] = v[q][1]; t[2] = v[q][2]; t[3] = v[q][3]; } }
    __syncthreads();
    { const int nrow = tid >> 3, k8 = tid & 7; const int ncol = (nrow & 32) + perm32(nrow & 31);
      UNR for (int t = 0; t < 4; ++t) {
        float v[8]; UNR for (int jj = 0; jj < 8; ++jj) v[jj] = fl[t * 4160 + (k8 * 8 + jj) * 65 + ncol];
        u32x4 w; w.x = pk_bf16(v[0], v[1]); w.y = pk_bf16(v[2], v[3]); w.z = pk_bf16(v[4], v[5]); w.w = pk_bf16(v[6], v[7]);
        *(u32x4*)(dst + (size_t)(nt_ * 64 + nrow) * K + (kt_ + t) * 64 + k8 * 8) = w; } }
  }
}

DEV void phase_h(const Params& p, char* lds) {
  const int tid = ltid(), wid = tid >> 6, lane = tid & 63;
  float* gsc = (float*)lds; float* sh = gsc + 2048; float* wif = sh + 2048;
  const float* modp = (const float*)(p.ws + OFF_MODP);
  u16* H = (u16*)(p.ws + OFF_H); float* IFG = (float*)(p.ws + OFF_IFG);
  for (int rb = blockIdx.x; rb < NTOK / 64; rb += gridDim.x) {
    const int b = (rb * 64) / SEQ;
    __syncthreads();
    for (int i = tid; i < 2048; i += NTHR) { float s0 = p.b_ada[i], s1 = p.b_ada[2048 + i];
      UNR for (int kp = 0; kp < 8; ++kp) { s0 += modp[(size_t)(kp * 2 + b) * 6144 + i]; s1 += modp[(size_t)(kp * 2 + b) * 6144 + 2048 + i]; }
      gsc[i] = p.norm_gain[i] * (1.0f + s1); sh[i] = s0; }
    if ((rb & 127) == 0) for (int i = tid; i < 2048; i += NTHR) { float s2 = p.b_ada[4096 + i];
      UNR for (int kp = 0; kp < 8; ++kp) s2 += modp[(size_t)(kp * 2 + b) * 6144 + 4096 + i];
      ((float*)(p.ws + OFF_MOD))[b * 6144 + 4096 + i] = s2; }
    for (int i = tid; i < 4096; i += NTHR) { const int k = i >> 1, hf = i & 1; const f32x4 wv4 = *(const f32x4*)(p.w_in + (size_t)k * INC + 9216 + hf * 4);
      UNR for (int e = 0; e < 4; ++e) wif[(hf * 4 + e) * 2048 + k] = wv4[e]; }
    __syncthreads();
    const float* xr0 = p.x + (size_t)(rb * 64 + wid * 8) * DM + lane * 4;
    f32x4 xn[8];
    UNR for (int i = 0; i < 8; ++i) xn[i] = __builtin_nontemporal_load((const f32x4*)(xr0 + 256 * i));
#pragma unroll 1
    for (int rr = 0; rr < 8; ++rr) {
      const int row = rb * 64 + wid * 8 + rr;
      f32x4 xv[8]; float ss = 0.f;
      UNR for (int i = 0; i < 8; ++i) { xv[i] = xn[i]; ss += xv[i][0] * xv[i][0] + xv[i][1] * xv[i][1] + xv[i][2] * xv[i][2] + xv[i][3] * xv[i][3]; }
      if (rr < 7) { UNR for (int i = 0; i < 8; ++i) xn[i] = __builtin_nontemporal_load((const f32x4*)(xr0 + (size_t)(rr + 1) * DM + 256 * i)); }
      ss = wave_sum(ss);
      const float rstd = rsqrtf(ss * (1.0f / 2048.0f) + 1e-6f);
      float a[8]; UNR for (int j = 0; j < 8; ++j) a[j] = 0.f;
      UNR for (int i = 0; i < 8; ++i) { const int c0 = lane * 4 + 256 * i;
        const f32x4 gv = *(const f32x4*)(gsc + c0), sv = *(const f32x4*)(sh + c0);
        const f32x4 hv = xv[i] * rstd * gv + sv;
        UNR for (int j = 0; j < 8; ++j) { const f32x4 wj = *(const f32x4*)(wif + j * 2048 + c0); a[j] += hv[0] * wj[0] + hv[1] * wj[1] + hv[2] * wj[2] + hv[3] * wj[3]; }
        u32x2 w; w.x = pk_bf16(hv[0], hv[1]); w.y = pk_bf16(hv[2], hv[3]);
        *(u32x2*)(H + (size_t)row * DM + c0) = w;
        asm volatile("" ::: "memory"); }
      UNR for (int j = 0; j < 8; ++j) a[j] = wave_sum(a[j]);
      if (lane < 8) { float v = a[0]; for (int j = 1; j < 8; ++j) v = (lane == j) ? a[j] : v; IFG[(size_t)row * 8 + lane] = v + p.b_gate_if[lane]; }
    }
  }
}

DEV void phase_gemm_main(const Params& p, char* lds) {
  const u16* H = (const u16*)(p.ws + OFF_H); const u16* W = (const u16*)(p.ws + OFF_WMAIN); char* ws = p.ws;
  gemm_stream(H, DM, W, DM, DM, 64, 36, (lchar*)lds, [=](const f32x4 (&acc)[2][2][4][2], int pm, int pn, int wr, int wc, int fr, int fq) {
    const int cb = pn * 256, buf = cb / 3072, cc = cb % 3072;
    u16* O = (u16*)(ws + (buf == 0 ? OFF_P1 : (buf == 1 ? OFF_P2 : OFF_P3)));
    UNR for (int ai = 0; ai < 2; ++ai) UNR for (int m = 0; m < 4; ++m) { u16* rp = O + (size_t)(pm * 256 + ROW_(ai, m)) * 3072 + cc;
      UNR for (int bj = 0; bj < 2; ++bj) { const f32x4 v0 = acc[ai][bj][m][0], v1 = acc[ai][bj][m][1]; u32x4 w;
        w.x = pk_bf16(v0[0], v0[1]); w.y = pk_bf16(v0[2], v0[3]); w.z = pk_bf16(v1[0], v1[1]); w.w = pk_bf16(v1[2], v1[3]);
        *(u32x4*)(rp + COLP_(bj)) = w; } }
  });
}

template <int OFF> DEV u32x2 tr_read(unsigned addr) { u32x2 r; asm volatile("ds_read_b64_tr_b16 %0, %1 offset:%2" : "=&v"(r) : "v"(addr), "i"(OFF) : "memory"); return r; }
#define TR2(c) v0[c] = tr_read<(c) * 32>(vb); v1[c] = tr_read<1088 + (c) * 32>(vb);
constexpr int ABUF = 69632, AVOFF = 34816;
DEV void attn_chunk(const Params& p, char* lds_, int ci) {
  lchar* lds = (lchar*)lds_;
  const int tid = ltid(), wid = __builtin_amdgcn_readfirstlane(tid >> 6), lane = tid & 63, fr = lane & 15, g = lane >> 4;
  const int pat = ci >> 8, rem = ci & 255;
  const int d = pat == 0 ? 1 : (pat == 1 ? 4 : 16), cps = 16 / d;
  const int cpos = rem % cps, stream = rem / cps, r = stream % d, bh = stream / d, b = bh >> 3, h = bh & 7;
  const int n0 = cpos * 4;
  const u16* P1 = (const u16*)(p.ws + OFF_P1) + (size_t)b * SEQ * 3072 + h * 128;
  const int lrow = tid >> 4, lch = tid & 15;
  u32x4 kreg[4], vreg[4];
  __syncthreads();
  const int qi = 16 * wid + fr;
  bf16x8 qn[4];
  { u32x4 kr2[4], vr2[4];
    if (n0 > 0) {
      UNR for (int ps = 0; ps < 4; ++ps) { const int tk = ((n0 - 1) * 128 + lrow + 32 * ps) * d + r; const u16* s = P1 + (size_t)tk * 3072 + lch * 8; kreg[ps] = *(const u32x4*)(s + 1024); vreg[ps] = *(const u32x4*)(s + 2048); }
    } else {
      UNR for (int ps = 0; ps < 4; ++ps) { kreg[ps] = (u32x4){0u, 0u, 0u, 0u}; vreg[ps] = (u32x4){0u, 0u, 0u, 0u}; }
    }
    UNR for (int ps = 0; ps < 4; ++ps) { const int tk = (n0 * 128 + lrow + 32 * ps) * d + r; const u16* s = P1 + (size_t)tk * 3072 + lch * 8; kr2[ps] = *(const u32x4*)(s + 1024); vr2[ps] = *(const u32x4*)(s + 2048); }
    { const u16* qp = P1 + (size_t)((n0 * 128 + qi) * d + r) * 3072 + 8 * g;
      UNR for (int s = 0; s < 4; ++s) qn[s] = *(const bf16x8*)(qp + 32 * s); }
    UNR for (int ps = 0; ps < 4; ++ps) { *(LAS u32x4*)(lds + (lrow + 32 * ps) * 272 + lch * 16) = kreg[ps]; *(LAS u32x4*)(lds + AVOFF + (lrow + 32 * ps) * 272 + lch * 16) = vreg[ps]; }
    UNR for (int ps = 0; ps < 4; ++ps) { *(LAS u32x4*)(lds + ABUF + (lrow + 32 * ps) * 272 + lch * 16) = kr2[ps]; *(LAS u32x4*)(lds + ABUF + AVOFF + (lrow + 32 * ps) * 272 + lch * 16) = vr2[ps]; } }
  __syncthreads();
  const float c1 = 0.08838834764831845f * 1.4426950408889634f, c2 = exp2f(-(float)(h + 1)) * (float)d * 1.4426950408889634f;
#pragma unroll 1
  for (int i = 0; i < 4; ++i) {
    const int nq = n0 + i;
    lchar* prevB = lds + (i & 1) * ABUF; lchar* curB = lds + ((i + 1) & 1) * ABUF;
    const int tq = (nq * 128 + qi) * d + r;
    bf16x8 qf[4];
    UNR for (int s = 0; s < 4; ++s) qf[s] = qn[s];
    if (i < 3) {
      UNR for (int ps = 0; ps < 4; ++ps) { const int tk = ((nq + 1) * 128 + lrow + 32 * ps) * d + r; const u16* s = P1 + (size_t)tk * 3072 + lch * 8; kreg[ps] = *(const u32x4*)(s + 1024); vreg[ps] = *(const u32x4*)(s + 2048); }
      const u16* qp = P1 + (size_t)(((nq + 1) * 128 + qi) * d + r) * 3072 + 8 * g;
      UNR for (int s = 0; s < 4; ++s) qn[s] = *(const bf16x8*)(qp + 32 * s);
    }
    const int u = wid >> 1;
    int gofs[5];
#pragma unroll
    for (int kq = 0; kq < 5; ++kq) { const int ks = u + kq; gofs[kq] = (((ks < 4) ? (i & 1) : ((i + 1) & 1)) * ABUF) + (ks & 3) * 8704; }
    f32x4 sc[5][2];
    { const int koff = (8 * (fr >> 2) + (fr & 3)) * 272 + 16 * g;
      bf16x8 kfa[8], kfb[8];
#pragma unroll
      for (int q = 0; q < 8; ++q) kfa[q] = *(const LAS bf16x8*)(lds + gofs[0] + koff + (q >> 2) * 1088 + 64 * (q & 3));
#pragma unroll
      for (int kq = 0; kq < 5; ++kq) {
        if (kq < 4) {
#pragma unroll
          for (int q = 0; q < 8; ++q) { const bf16x8 v = *(const LAS bf16x8*)(lds + gofs[kq + 1] + koff + (q >> 2) * 1088 + 64 * (q & 3)); if (kq & 1) kfa[q] = v; else kfb[q] = v; }
        }
        SCHED;
#pragma unroll
        for (int t = 0; t < 2; ++t) {
          f32x4 a = {0.f, 0.f, 0.f, 0.f};
#pragma unroll
          for (int s = 0; s < 4; ++s) a = __builtin_amdgcn_mfma_f32_16x16x32_bf16((kq & 1) ? kfb[t * 4 + s] : kfa[t * 4 + s], qf[s], a, 0, 0, 0);
          sc[kq][t] = a;
        }
        SCHED;
      } }
    const int dbl = 16 * (wid & 1) + fr - 8 * g + 128;
    const float b0 = -c2 * (float)dbl;
    float mx = -INFINITY;
#pragma unroll
    for (int kq = 0; kq < 5; ++kq) {
      const bool gval = (nq > 0) || (u + kq >= 4);
#pragma unroll
      for (int t = 0; t < 2; ++t) {
#pragma unroll
        for (int j = 0; j < 4; ++j) {
          const int kk = 32 * kq + 4 * t + j;
          float s = __builtin_fmaf(sc[kq][t][j], c1, __builtin_fmaf(c2, (float)kk, b0));
          bool valid = gval;
          if (kq == 0) valid = valid && (dbl - kk <= 128);
          if (kq == 4) valid = valid && (dbl - kk >= 0);
          s = valid ? s : -INFINITY;
          sc[kq][t][j] = s; mx = fmaxf(mx, s);
        } } }
    mx = fmaxf(mx, __shfl_xor(mx, 16)); mx = fmaxf(mx, __shfl_xor(mx, 32));
    float sum = 0.f;
#pragma unroll
    for (int kq = 0; kq < 5; ++kq) {
#pragma unroll
      for (int t = 0; t < 2; ++t) {
#pragma unroll
        for (int j = 0; j < 4; ++j) { const float e = __builtin_amdgcn_exp2f(sc[kq][t][j] - mx); sc[kq][t][j] = e; sum += e; } } }
    sum += __shfl_xor(sum, 16); sum += __shfl_xor(sum, 32);
    const float inv = __builtin_amdgcn_rcpf(sum);
    f32x4 oc[8];
#pragma unroll
    for (int c = 0; c < 8; ++c) oc[c] = (f32x4){0.f, 0.f, 0.f, 0.f};
    const unsigned vlane = (unsigned)(size_t)lds + AVOFF + (8 * g + (fr >> 2)) * 272 + 8 * (fr & 3);
    u32x2 va0[8], va1[8], vb0[8], vb1[8];
#define TRA(c) va0[c] = tr_read<(c) * 32>(vb); va1[c] = tr_read<1088 + (c) * 32>(vb);
#define TRB(c) vb0[c] = tr_read<(c) * 32>(vb); vb1[c] = tr_read<1088 + (c) * 32>(vb);
    { const unsigned vb = vlane + gofs[0]; TRA(0) TRA(1) TRA(2) TRA(3) TRA(4) TRA(5) TRA(6) TRA(7) }
#pragma unroll
    for (int kq = 0; kq < 5; ++kq) {
      union { bf16x8 v; unsigned u[4]; } pf;
      pf.u[0] = pk_bf16(sc[kq][0][0], sc[kq][0][1]); pf.u[1] = pk_bf16(sc[kq][0][2], sc[kq][0][3]);
      pf.u[2] = pk_bf16(sc[kq][1][0], sc[kq][1][1]); pf.u[3] = pk_bf16(sc[kq][1][2], sc[kq][1][3]);
      asm volatile("s_waitcnt lgkmcnt(0)" ::: "memory"); SCHED;
      if (kq < 4) { const unsigned vb = vlane + gofs[kq + 1];
        if (kq & 1) { TRA(0) TRA(1) TRA(2) TRA(3) TRA(4) TRA(5) TRA(6) TRA(7) } else { TRB(0) TRB(1) TRB(2) TRB(3) TRB(4) TRB(5) TRB(6) TRB(7) } }
#pragma unroll
      for (int c = 0; c < 8; ++c) {
        union { bf16x8 v; unsigned u[4]; } vf;
        if (kq & 1) { vf.u[0] = vb0[c].x; vf.u[1] = vb0[c].y; vf.u[2] = vb1[c].x; vf.u[3] = vb1[c].y; }
        else { vf.u[0] = va0[c].x; vf.u[1] = va0[c].y; vf.u[2] = va1[c].x; vf.u[3] = va1[c].y; }
        oc[c] = __builtin_amdgcn_mfma_f32_16x16x32_bf16(vf.v, pf.v, oc[c], 0, 0, 0);
      }
    }
    { u16* O = (u16*)((char*)p.out + DO_OATT) + ((size_t)pat * NTOK + (size_t)(b * SEQ + tq)) * 1024 + h * 128 + 4 * g;
#pragma unroll
      for (int c = 0; c < 8; ++c) { u32x2 w; w.x = pk_bf16(oc[c][0] * inv, oc[c][1] * inv); w.y = pk_bf16(oc[c][2] * inv, oc[c][3] * inv); *(u32x2*)(O + 16 * c) = w; }
      if (g == 0) ((float*)(p.ws + OFF_LSE))[((size_t)pat * NTOK + (size_t)(b * SEQ + tq)) * 8 + h] = (mx + __builtin_amdgcn_logf(sum)) * 0.6931471805599453f; }
    __syncthreads();
    if (i < 3) {
      UNR for (int ps = 0; ps < 4; ++ps) { *(LAS u32x4*)(prevB + (lrow + 32 * ps) * 272 + lch * 16) = kreg[ps]; *(LAS u32x4*)(prevB + AVOFF + (lrow + 32 * ps) * 272 + lch * 16) = vreg[ps]; }
    }
    __syncthreads();
  }
}

DEV void mprep_item(const Params& p, char* lds, int item) {
  const int tid = ltid();
  const int k = item & 31, h = (item >> 5) & 3, b = item >> 7;
  const int tok0 = b * SEQ + k * 256;
  char* Ts = lds;
  float* sa = (float*)(lds + 135168); float* sb = sa + 256; float* sw = sb + 256; float* red = sw + 256;
  const float* IFG = (const float*)(p.ws + OFF_IFG);
  const u16* P2 = (const u16*)(p.ws + OFF_P2);
  __syncthreads();
  float iv = 0.f, av = 0.f, cv = 0.f;
  if (tid < 256) { const float f = IFG[(size_t)(tok0 + tid) * 8 + 4 + h]; iv = IFG[(size_t)(tok0 + tid) * 8 + h];
    av = fminf(f, 0.f) - log1pf(__expf(-fabsf(f))); sa[tid] = av; }
  __syncthreads();
  for (int off = 1; off < 256; off <<= 1) { float t = 0.f; if (tid < 256 && tid >= off) t = sa[tid - off]; __syncthreads(); if (tid < 256) { av += t; sa[tid] = av; } __syncthreads(); }
  if (tid < 256) { cv = iv - av; sb[tid] = cv; }
  float cm = cv;
  __syncthreads();
  for (int off = 1; off < 256; off <<= 1) { float t = -INFINITY; if (tid < 256 && tid >= off) t = sb[tid - off]; __syncthreads(); if (tid < 256) { cm = fmaxf(cm, t); sb[tid] = cm; } __syncthreads(); }
  const float cmall = sb[255], Aall = sa[255];
  if (tid < 256) { const size_t ix = (size_t)(tok0 + tid) * 4 + h;
    ((float*)(p.ws + OFF_SA))[ix] = av; ((float*)(p.ws + OFF_SC))[ix] = cv; ((float*)(p.ws + OFF_SCM))[ix] = cm;
    sw[tid] = __expf(cv - cmall); }
  if (tid == 0) { ((float*)(p.ws + OFF_IA))[item] = Aall; ((float*)(p.ws + OFF_IG))[item] = Aall + cmall; }
  __syncthreads();
  u16* QC = (u16*)(p.ws + OFF_QC); u16* KC = (u16*)(p.ws + OFF_KC);
  float* nup = red;
  { const int cgp = tid & 31, rg = tid >> 5, e0 = cgp * 8, ch = h * 256 + e0, t0 = rg * 16;
#pragma unroll 1
    for (int pass = 0; pass < 2; ++pass) {
      const int wofs = pass * 1024 + ch;
      float wv[4][8], bv[8];
      UNR for (int e = 0; e < 8; ++e) bv[e] = p.conv_b[wofs + e];
      UNR for (int j = 0; j < 4; ++j) { UNR for (int e = 0; e < 8; ++e) wv[j][e] = p.conv_w[(size_t)j * 2048 + wofs + e]; }
      float ns[8]; UNR for (int e = 0; e < 8; ++e) ns[e] = 0.f;
#pragma unroll 1
      for (int half = 0; half < 2; ++half) {
      u32x4 rows[11];
      UNR for (int i = 0; i < 11; ++i) { const int pos = k * 256 + t0 + half * 8 + i - 3;
        rows[i] = (pos >= 0) ? *(const u32x4*)(P2 + (size_t)(tok0 + t0 + half * 8 + i - 3) * 3072 + pass * 1024 + ch) : (u32x4){0u, 0u, 0u, 0u}; }
      UNR for (int i = 0; i < 8; ++i) {
        float acc8[8]; UNR for (int e = 0; e < 8; ++e) acc8[e] = bv[e];
        UNR for (int j = 0; j < 4; ++j) { const u32x4 rv = rows[i + j]; const unsigned ru[4] = {rv.x, rv.y, rv.z, rv.w};
          UNR for (int e = 0; e < 4; ++e) { acc8[2 * e] += wv[j][2 * e] * bflo(ru[e]); acc8[2 * e + 1] += wv[j][2 * e + 1] * bfhi(ru[e]); } }
        const int t = t0 + half * 8 + i;
        if (pass == 0) {
          UNR for (int e = 0; e < 8; ++e) acc8[e] = siluf_(acc8[e]);
          u32x4 o; o.x = pk_bf16(acc8[0], acc8[1]); o.y = pk_bf16(acc8[2], acc8[3]); o.z = pk_bf16(acc8[4], acc8[5]); o.w = pk_bf16(acc8[6], acc8[7]);
          *(u32x4*)(QC + (size_t)(tok0 + t) * 1024 + ch) = o;
        } else {
          const float w = sw[t]; float kw[8];
          UNR for (int e = 0; e < 8; ++e) { acc8[e] = siluf_(acc8[e]) * 0.0625f; kw[e] = acc8[e] * w; }
          u32x4 o; o.x = pk_bf16(acc8[0], acc8[1]); o.y = pk_bf16(acc8[2], acc8[3]); o.z = pk_bf16(acc8[4], acc8[5]); o.w = pk_bf16(acc8[6], acc8[7]);
          *(u32x4*)(KC + (size_t)(tok0 + t) * 1024 + ch) = o;
          o.x = pk_bf16(kw[0], kw[1]); o.y = pk_bf16(kw[2], kw[3]); o.z = pk_bf16(kw[4], kw[5]); o.w = pk_bf16(kw[6], kw[7]);
          *(u32x4*)(Ts + t * 528 + e0 * 2) = o;
          const unsigned ou[4] = {o.x, o.y, o.z, o.w};
          UNR for (int e = 0; e < 4; ++e) { ns[2 * e] += bflo(ou[e]); ns[2 * e + 1] += bfhi(ou[e]); }
        }
        asm volatile("" ::: "memory");
      }
      }
      if (pass == 1) { *(f32x4*)(nup + rg * 256 + e0) = (f32x4){ns[0], ns[1], ns[2], ns[3]}; *(f32x4*)(nup + rg * 256 + e0 + 4) = (f32x4){ns[4], ns[5], ns[6], ns[7]}; }
    } }
  __syncthreads();
  const int wid = __builtin_amdgcn_readfirstlane(tid >> 6), lane = tid & 63, li = lane & 15, lg = lane >> 4;
  const unsigned trl = (unsigned)(size_t)(lchar*)lds + (8 * lg + (li >> 2)) * 528 + 8 * (li & 3);
  { u16* KWT = (u16*)(p.ws + OFF_KWT) + (size_t)item * 65536;
#pragma unroll 1
    for (int j4 = 0; j4 < 4; ++j4) { u32x2 ra[4], rb[4];
      UNR for (int q = 0; q < 4; ++q) { const int uq = wid * 16 + j4 * 4 + q, eb = (uq & 15) * 16, sb2 = (uq >> 4) * 32; const unsigned ad = trl + sb2 * 528 + eb * 2;
        ra[q] = tr_read<0>(ad); rb[q] = tr_read<4 * 528>(ad); }
      asm volatile("s_waitcnt lgkmcnt(0)" ::: "memory"); SCHED;
      UNR for (int q = 0; q < 4; ++q) { const int uq = wid * 16 + j4 * 4 + q, eb = (uq & 15) * 16, sb2 = (uq >> 4) * 32;
        u32x4 o; o.x = ra[q].x; o.y = ra[q].y; o.z = rb[q].x; o.w = rb[q].y; *(u32x4*)(KWT + (size_t)(eb + li) * 256 + sb2 + 8 * lg) = o; } }
    if (tid < 256) { float s = 0.f; UNR for (int q = 0; q < 16; ++q) s += nup[q * 256 + tid]; ((float*)(p.ws + OFF_NU))[(size_t)item * 256 + tid] = s; } }
  __syncthreads();
  { u32x4 vr[16];
    UNR for (int itr = 0; itr < 16; ++itr) { const int u = tid + NTHR * itr, t = u >> 5, e0 = (u & 31) * 8; vr[itr] = *(const u32x4*)(P2 + (size_t)(tok0 + t) * 3072 + 2048 + h * 256 + e0); }
    UNR for (int itr = 0; itr < 16; ++itr) { const int u = tid + NTHR * itr, t = u >> 5, e0 = (u & 31) * 8; *(u32x4*)(Ts + t * 528 + e0 * 2) = vr[itr]; } }
  __syncthreads();
  { u16* VT = (u16*)((char*)p.out + DO_VT) + (size_t)item * 65536;
#pragma unroll 1
    for (int j4 = 0; j4 < 4; ++j4) { u32x2 ra[4], rb[4];
      UNR for (int q = 0; q < 4; ++q) { const int uq = wid * 16 + j4 * 4 + q, eb = (uq & 15) * 16, sb2 = (uq >> 4) * 32; const unsigned ad = trl + sb2 * 528 + eb * 2;
        ra[q] = tr_read<0>(ad); rb[q] = tr_read<4 * 528>(ad); }
      asm volatile("s_waitcnt lgkmcnt(0)" ::: "memory"); SCHED;
      UNR for (int q = 0; q < 4; ++q) { const int uq = wid * 16 + j4 * 4 + q, eb = (uq & 15) * 16, sb2 = (uq >> 4) * 32;
        u32x4 o; o.x = ra[q].x; o.y = ra[q].y; o.z = rb[q].x; o.w = rb[q].y; *(u32x4*)(VT + (size_t)(eb + li) * 256 + sb2 + 8 * lg) = o; } } }
}


DEV void u_item(const Params& p, char* lds, int item) {
  WLANE; lchar* shm = (lchar*)lds;
  f32x4 acc[2][2][4][2]; acc_zero(acc);
  gemm_kloop(acc, (const u16*)((char*)p.out + DO_VT) + (size_t)item * 65536, 256, (const u16*)(p.ws + OFF_KWT) + (size_t)item * 65536, 256, 256, shm);
  { RELANE; u16* rp = (u16*)(p.ws + OFF_KWT) + (size_t)item * 65536 + (size_t)ROW_(0, 0) * 256 + COLP_(0);
    UNR for (int ai = 0; ai < 2; ++ai) UNR for (int m = 0; m < 4; ++m) { u16* q = rp + (ai * 128 + m * 16) * 256; asm volatile("" : "+v"(q) :: "memory");
      UNR for (int bj = 0; bj < 2; ++bj) { const f32x4 v0 = acc[ai][bj][m][0], v1 = acc[ai][bj][m][1]; u32x4 w;
        w.x = pk_bf16(v0[0], v0[1]); w.y = pk_bf16(v0[2], v0[3]); w.z = pk_bf16(v1[0], v1[1]); w.w = pk_bf16(v1[2], v1[3]); *(u32x4*)(q + bj * 128) = w; } } }
}

DEV void phase_d1(const Params& p, char* lds) {
  const bool attn_first = (blockIdx.x >> 3) & 1;
  if (attn_first) for (int ci = blockIdx.x; ci < 768; ci += gridDim.x) attn_chunk(p, lds, ci);
  for (int item = blockIdx.x; item < 256; item += gridDim.x) { mprep_item(p, lds, item);
    asm volatile("s_waitcnt vmcnt(0)" ::: "memory"); __syncthreads();
    u_item(p, lds, item); }
#if PROBE_DUP == 20
  for (int item = blockIdx.x; item < 256; item += gridDim.x) mprep_item(p, lds, item);
#endif
#if PROBE_DUP == 21
  for (int ci = blockIdx.x; ci < 768; ci += gridDim.x) attn_chunk(p, lds, ci);
#endif
  if (!attn_first) for (int ci = blockIdx.x; ci < 768; ci += gridDim.x) attn_chunk(p, lds, ci);
}

DEV void phase_scan(const Params& p, char* lds) {
  const float* IA = (const float*)(p.ws + OFF_IA); const float* IG = (const float*)(p.ws + OFF_IG);
  const int nthreads = gridDim.x * NTHR;
  for (int gid = blockIdx.x * NTHR + ltid(); gid < 8 * 16384; gid += nthreads) {
    const int bh = gid >> 14, idx = (gid & 16383) * 4;
    f32x4 C = {0.f, 0.f, 0.f, 0.f}; float m = 0.f;
    const u16* Ub = (const u16*)(p.ws + OFF_KWT) + (size_t)(bh * 32) * 65536 + idx;
    u32x2 ua[8], ub[8];
    UNR for (int j = 0; j < 8; ++j) ua[j] = *(const u32x2*)(Ub + (size_t)j * 65536);
#pragma unroll
    for (int kb = 0; kb < 4; ++kb) {
      if (kb < 3) { UNR for (int j = 0; j < 8; ++j) { const u32x2 v = *(const u32x2*)(Ub + (size_t)((kb + 1) * 8 + j) * 65536); if (kb & 1) ua[j] = v; else ub[j] = v; } }
      UNR for (int j = 0; j < 8; ++j) { const int item = bh * 32 + kb * 8 + j;
        u32x2 w; w.x = pk_bf16(C[0], C[1]); w.y = pk_bf16(C[2], C[3]);
        *(u32x2*)((u16*)(p.ws + OFF_CT) + (size_t)item * 65536 + idx) = w;
        if (idx == 0) ((float*)(p.ws + OFF_MK))[item] = m;
        const float A = IA[item], G = IG[item], mn = fmaxf(A + m, G), al = __expf(A + m - mn), be = __expf(G - mn);
        const u32x2 uv = (kb & 1) ? ub[j] : ua[j];
        const f32x4 u = {bflo(uv.x), bfhi(uv.x), bflo(uv.y), bfhi(uv.y)};
        C = C * al + u * be; m = mn; } }
  }
  for (int gid = blockIdx.x * NTHR + ltid(); gid < 2048; gid += nthreads) {
    const int bh = gid >> 8, e = gid & 255; float n = 0.f, m = 0.f;
    for (int k = 0; k < 32; ++k) { const int item = bh * 32 + k;
      ((float*)(p.ws + OFF_NK))[(size_t)item * 256 + e] = n;
      const float A = IA[item], G = IG[item], mn = fmaxf(A + m, G), al = __expf(A + m - mn), be = __expf(G - mn);
      n = n * al + ((const float*)(p.ws + OFF_NU))[(size_t)item * 256 + e] * be; m = mn; }
  }
}

DEV void mout_item(const Params& p, char* lds, int item) {
  WLANE; const int tid = ltid(); lchar* shm = (lchar*)lds;
  const int k = item & 31, h = (item >> 5) & 3, b = item >> 7; (void)k;
  const int tok0 = b * SEQ + (item & 31) * 256;
  float* sMt = (float*)(lds + 131072); float* sWin = sMt + 256; float* sCs = sWin + 256; float* sEm = sCs + 256; float* sQn = sEm + 256;
  float* sRow = sQn + 256;
  float* sR1 = (float*)lds; float* sR2 = sR1 + 1024;
  const u16* QC = (const u16*)(p.ws + OFF_QC) + (size_t)tok0 * 1024 + h * 256;
  const u16* KC = (const u16*)(p.ws + OFF_KC) + (size_t)tok0 * 1024 + h * 256;
  const float mk = ((const float*)(p.ws + OFF_MK))[item];
  __syncthreads();
  if (tid < 256) { const size_t ix = (size_t)(tok0 + tid) * 4 + h;
    const float a = ((const float*)(p.ws + OFF_SA))[ix], c = ((const float*)(p.ws + OFF_SC))[ix], cm = ((const float*)(p.ws + OFF_SCM))[ix];
    const float Mt = fmaxf(mk, cm); sMt[tid] = Mt; sWin[tid] = __expf(mk - Mt); sCs[tid] = c; sEm[tid] = __expf(-(a + Mt)); }
  { const float* NK = (const float*)(p.ws + OFF_NK) + (size_t)item * 256;
    const f32x4 nv = *(const f32x4*)(NK + lane * 4);
#pragma unroll 1
    for (int r8 = 0; r8 < 4; ++r8) { u32x2 qv[8];
      UNR for (int j = 0; j < 8; ++j) qv[j] = *(const u32x2*)(QC + (size_t)(wid * 32 + r8 * 8 + j) * 1024 + lane * 4);
      UNR for (int j = 0; j < 8; ++j) { float s = bflo(qv[j].x) * nv[0] + bfhi(qv[j].x) * nv[1] + bflo(qv[j].y) * nv[2] + bfhi(qv[j].y) * nv[3];
        s = wave_sum(s); if (lane == 0) sQn[wid * 32 + r8 * 8 + j] = s; } } }
  __syncthreads();
  f32x4 acc[2][2][4][2]; acc_zero(acc);
  gemm_kloop(acc, launder(QC), 1024, launder(KC), 1024, 256, shm);
  { RELANE; u16* PB = launder((u16*)(p.ws + OFF_PB) + (size_t)item * 65536);
    UNR for (int ai = 0; ai < 2; ++ai) UNR for (int m = 0; m < 4; ++m) { const int t = ROW_(ai, m); const float Mt = sMt[t]; float rs = 0.f;
      UNR for (int bj = 0; bj < 2; ++bj) { const int s0 = COLP_(bj); float pv[8];
        const f32x4 c0 = *(const f32x4*)(sCs + s0), c1 = *(const f32x4*)(sCs + s0 + 4);
        UNR for (int j = 0; j < 4; ++j) { const float m0 = (s0 + j <= t) ? 1.0f : 0.0f, m1 = (s0 + 4 + j <= t) ? 1.0f : 0.0f;
          pv[j] = m0 * acc[ai][bj][m][0][j] * __expf(fminf(c0[j] - Mt, 0.f)); pv[4 + j] = m1 * acc[ai][bj][m][1][j] * __expf(fminf(c1[j] - Mt, 0.f)); rs += pv[j] + pv[4 + j]; }
        u32x4 w; w.x = pk_bf16(pv[0], pv[1]); w.y = pk_bf16(pv[2], pv[3]); w.z = pk_bf16(pv[4], pv[5]); w.w = pk_bf16(pv[6], pv[7]); *(u32x4*)(PB + (size_t)t * 256 + s0) = w; }
      rs += __shfl_xor(rs, 16); rs += __shfl_xor(rs, 32);
      if (fq == 0) sRow[wc * 256 + t] = rs;
      asm volatile("" ::: "memory"); } }
  asm volatile("s_waitcnt vmcnt(0)" ::: "memory"); __syncthreads();
  acc_zero(acc);
  gemm_kloop(acc, launder(QC), 1024, launder((const u16*)(p.ws + OFF_CT) + (size_t)item * 65536), 256, 256, shm);
  { RELANE;
    UNR for (int ai = 0; ai < 2; ++ai) UNR for (int m = 0; m < 4; ++m) { const float w = sWin[ROW_(ai, m)];
      UNR for (int bj = 0; bj < 2; ++bj) UNR for (int n = 0; n < 2; ++n) acc[ai][bj][m][n] = acc[ai][bj][m][n] * w; } }
  gemm_kloop(acc, launder((const u16*)(p.ws + OFF_PB) + (size_t)item * 65536), 256, launder((const u16*)((char*)p.out + DO_VT) + (size_t)item * 65536), 256, 256, shm);
  { RELANE; const u16* P3 = launder((const u16*)(p.ws + OFF_P3) + (size_t)tok0 * 3072 + 1024 + h * 256);
    UNR for (int ai = 0; ai < 2; ++ai) { u32x4 ov[4][2];
      UNR for (int m = 0; m < 4; ++m) UNR for (int bj = 0; bj < 2; ++bj) ov[m][bj] = *(const u32x4*)(P3 + (size_t)ROW_(ai, m) * 3072 + COLP_(bj));
      UNR for (int m = 0; m < 4; ++m) { const int t = ROW_(ai, m);
        const float den = sRow[t] + sRow[256 + t] + sRow[512 + t] + sRow[768 + t] + sWin[t] * sQn[t];
        const float rden = __builtin_amdgcn_rcpf(fmaxf(fabsf(den), sEm[t])); float s1 = 0.f, s2 = 0.f;
        UNR for (int bj = 0; bj < 2; ++bj) { const u32x4 o4 = ov[m][bj];
          f32x4 v0 = acc[ai][bj][m][0] * rden, v1 = acc[ai][bj][m][1] * rden;
          v0[0] *= sigmoidf_(bflo(o4.x)); v0[1] *= sigmoidf_(bfhi(o4.x)); v0[2] *= sigmoidf_(bflo(o4.y)); v0[3] *= sigmoidf_(bfhi(o4.y));
          v1[0] *= sigmoidf_(bflo(o4.z)); v1[1] *= sigmoidf_(bfhi(o4.z)); v1[2] *= sigmoidf_(bflo(o4.w)); v1[3] *= sigmoidf_(bfhi(o4.w));
          acc[ai][bj][m][0] = v0; acc[ai][bj][m][1] = v1;
          s1 += v0[0] + v0[1] + v0[2] + v0[3] + v1[0] + v1[1] + v1[2] + v1[3];
          s2 += v0[0] * v0[0] + v0[1] * v0[1] + v0[2] * v0[2] + v0[3] * v0[3] + v1[0] * v1[0] + v1[1] * v1[1] + v1[2] * v1[2] + v1[3] * v1[3]; }
        s1 += __shfl_xor(s1, 16); s1 += __shfl_xor(s1, 32); s2 += __shfl_xor(s2, 16); s2 += __shfl_xor(s2, 32);
        if (fq == 0) { sR1[wc * 256 + t] = s1; sR2[wc * 256 + t] = s2; } }
      asm volatile("" : "+v"(acc[ai][0][0][0]), "+v"(acc[ai][0][1][0]), "+v"(acc[ai][0][2][0]), "+v"(acc[ai][0][3][0]) :: "memory"); } }
  __syncthreads();
  { RELANE; const u16* P3z = launder((const u16*)(p.ws + OFF_P3) + (size_t)tok0 * 3072 + 2048 + h * 256);
    u16* AM = launder((u16*)(p.ws + OFF_AM) + (size_t)tok0 * 1024 + h * 256); const float* gnp = launder(p.mgain + h * 256);
    f32x4 gn[2][2]; UNR for (int bj = 0; bj < 2; ++bj) { gn[bj][0] = *(const f32x4*)(gnp + COLP_(bj)); gn[bj][1] = *(const f32x4*)(gnp + COLP_(bj) + 4); }
    UNR for (int ai = 0; ai < 2; ++ai) { u32x4 zv[4][2];
      UNR for (int m = 0; m < 4; ++m) UNR for (int bj = 0; bj < 2; ++bj) zv[m][bj] = *(const u32x4*)(P3z + (size_t)ROW_(ai, m) * 3072 + COLP_(bj));
      UNR for (int m = 0; m < 4; ++m) { const int t = ROW_(ai, m);
        const float s1 = sR1[t] + sR1[256 + t] + sR1[512 + t] + sR1[768 + t], s2 = sR2[t] + sR2[256 + t] + sR2[512 + t] + sR2[768 + t];
        const float mu = s1 * (1.0f / 256.0f), var = fmaxf(s2 * (1.0f / 256.0f) - mu * mu, 0.f), rstd = rsqrtf(var + 1e-6f);
        UNR for (int bj = 0; bj < 2; ++bj) { const u32x4 z4 = zv[m][bj]; const f32x4 g0 = gn[bj][0], g1 = gn[bj][1]; const f32x4 v0 = acc[ai][bj][m][0], v1 = acc[ai][bj][m][1];
          const float y0 = (v0[0] - mu) * rstd * g0[0] * siluf_(bflo(z4.x)), y1 = (v0[1] - mu) * rstd * g0[1] * siluf_(bfhi(z4.x));
          const float y2 = (v0[2] - mu) * rstd * g0[2] * siluf_(bflo(z4.y)), y3 = (v0[3] - mu) * rstd * g0[3] * siluf_(bfhi(z4.y));
          const float y4 = (v1[0] - mu) * rstd * g1[0] * siluf_(bflo(z4.z)), y5 = (v1[1] - mu) * rstd * g1[1] * siluf_(bfhi(z4.z));
          const float y6 = (v1[2] - mu) * rstd * g1[2] * siluf_(bflo(z4.w)), y7 = (v1[3] - mu) * rstd * g1[3] * siluf_(bfhi(z4.w));
          u32x4 w; w.x = pk_bf16(y0, y1); w.y = pk_bf16(y2, y3); w.z = pk_bf16(y4, y5); w.w = pk_bf16(y6, y7); *(u32x4*)(AM + (size_t)t * 1024 + COLP_(bj)) = w; } }
      asm volatile("" ::: "memory"); } }
}

DEV void amerge_unit(const u16* __restrict__ OA, const float* __restrict__ LSE, const u16* __restrict__ P3, u16* __restrict__ AA, int u,
                     u32x4& a, u32x4& b, u32x4& c, u32x4& z, float& l0, float& l1, float& l2) {
  const int tok = u >> 7, c0 = (u & 127) * 8, h = c0 >> 7;
  l0 = LSE[(size_t)tok * 8 + h]; l1 = LSE[((size_t)NTOK + tok) * 8 + h]; l2 = LSE[((size_t)2 * NTOK + tok) * 8 + h];
  a = *(const u32x4*)(OA + (size_t)tok * 1024 + c0); b = *(const u32x4*)(OA + ((size_t)NTOK + tok) * 1024 + c0); c = *(const u32x4*)(OA + ((size_t)2 * NTOK + tok) * 1024 + c0);
  z = *(const u32x4*)(P3 + (size_t)tok * 3072 + c0);
}
DEV void amerge_fin(u16* __restrict__ AA, int u, const u32x4& a, const u32x4& b, const u32x4& c, const u32x4& z, float l0, float l1, float l2) {
  const int tok = u >> 7, c0 = (u & 127) * 8;
  const float mx = fmaxf(l0, fmaxf(l1, l2)); float w0 = __expf(l0 - mx), w1 = __expf(l1 - mx), w2 = __expf(l2 - mx);
  const float inv = __builtin_amdgcn_rcpf(w0 + w1 + w2); w0 *= inv; w1 *= inv; w2 *= inv;
  const unsigned au[4] = {a.x, a.y, a.z, a.w}, bu[4] = {b.x, b.y, b.z, b.w}, cu[4] = {c.x, c.y, c.z, c.w}, zu[4] = {z.x, z.y, z.z, z.w};
  unsigned o[4];
  UNR for (int e = 0; e < 4; ++e) {
    const float lo = (w0 * bflo(au[e]) + w1 * bflo(bu[e]) + w2 * bflo(cu[e])) * siluf_(bflo(zu[e]));
    const float hi = (w0 * bfhi(au[e]) + w1 * bfhi(bu[e]) + w2 * bfhi(cu[e])) * siluf_(bfhi(zu[e]));
    o[e] = pk_bf16(lo, hi); }
  u32x4 w; w.x = o[0]; w.y = o[1]; w.z = o[2]; w.w = o[3];
  *(u32x4*)(AA + (size_t)tok * 1024 + c0) = w;
}
DEV void phase_amerge(const Params& p) {
  const u16* OA = (const u16*)((char*)p.out + DO_OATT); const float* LSE = (const float*)(p.ws + OFF_LSE);
  const u16* P3 = (const u16*)(p.ws + OFF_P3); u16* AA = (u16*)(p.ws + OFF_AA);
  const int nthreads = gridDim.x * NTHR, N = NTOK * 128;
#pragma unroll 1
  for (int u = blockIdx.x * NTHR + ltid(); u < N; u += 4 * nthreads) {
    u32x4 a[4], b[4], c[4], z[4]; float l0[4], l1[4], l2[4];
    UNR for (int q = 0; q < 4; ++q) { const int uq = u + q * nthreads; if (uq < N) amerge_unit(OA, LSE, P3, AA, uq, a[q], b[q], c[q], z[q], l0[q], l1[q], l2[q]); }
    UNR for (int q = 0; q < 4; ++q) { const int uq = u + q * nthreads; if (uq < N) amerge_fin(AA, uq, a[q], b[q], c[q], z[q], l0[q], l1[q], l2[q]); }
  }
}
DEV void phase_d4(const Params& p, char* lds) {
  const bool merge_first = (blockIdx.x >> 3) & 1;
  if (merge_first) phase_amerge(p);
  for (int item = blockIdx.x; item < 256; item += gridDim.x) mout_item(p, lds, item);
#if PROBE_DUP == 22
  for (int item = blockIdx.x; item < 256; item += gridDim.x) mout_item(p, lds, item);
#endif
  if (!merge_first) phase_amerge(p);
#if PROBE_DUP == 23
  phase_amerge(p);
#endif
}

DEV size_t gate_off(int pm, int pg, int wid, int ai, int m, int bj, int lane) {
  return ((((((size_t)(pm * 16 + pg) * 8 + wid) * 2 + ai) * 4 + m) * 2 + bj) * 64 + lane) * 8;
}
DEV void phase_gemm_gates(const Params& p, char* lds) {
  const u16* H = (const u16*)(p.ws + OFF_H); const u16* W = (const u16*)(p.ws + OFF_WG); u16* P4 = (u16*)(p.ws + OFF_P4);
  gemm_stream(H, DM, W, DM, DM, 64, 16, (lchar*)lds, [=](const f32x4 (&acc)[2][2][4][2], int pm, int pn, int wr, int wc, int fr, int fq) {
    const int wid_ = wr * 4 + wc, lane_ = fq * 16 + fr;
    UNR for (int ai = 0; ai < 2; ++ai) UNR for (int m = 0; m < 4; ++m) {
      UNR for (int bj = 0; bj < 2; ++bj) { const f32x4 v0 = acc[ai][bj][m][0], v1 = acc[ai][bj][m][1]; u32x4 w;
        w.x = pk_bf16(sigmoidf_(v0[0]), sigmoidf_(v0[1])); w.y = pk_bf16(sigmoidf_(v0[2]), sigmoidf_(v0[3]));
        w.z = pk_bf16(sigmoidf_(v1[0]), sigmoidf_(v1[1])); w.w = pk_bf16(sigmoidf_(v1[2]), sigmoidf_(v1[3]));
        *(u32x4*)(P4 + gate_off(pm, pn, wid_, ai, m, bj, lane_)) = w; } }
  });
}

DEV void phase_gemm_merge(const Params& p, char* lds) {
  const u16* AA = (const u16*)(p.ws + OFF_AA); const u16* AM = (const u16*)(p.ws + OFF_AM);
  const u16* WA = (const u16*)(p.ws + OFF_WPA); const u16* WM = (const u16*)(p.ws + OFF_WPM);
  const u16* P4 = (const u16*)(p.ws + OFF_P4); u16* MG = (u16*)(p.ws + OFF_MG);
  gemm_stream2(AA, AM, 1024, WA, WM, 1024, 1024, 64, 8, (lchar*)lds, [=](f32x4 (&acc)[2][2][4][2], int pm, int pn, int seg, int wr, int wc) {
    RELANE; const u16* P4a = launder(P4); const int wid_ = wr * 4 + wc, lane_ = fq * 16 + fr;
    if (seg == 0) {
      UNR for (int ai = 0; ai < 2; ++ai) UNR for (int m = 0; m < 4; ++m) {
        UNR for (int bj = 0; bj < 2; ++bj) { const u32x4 ga = *(const u32x4*)(P4a + gate_off(pm, pn, wid_, ai, m, bj, lane_)), gb = *(const u32x4*)(P4a + gate_off(pm, 8 + pn, wid_, ai, m, bj, lane_));
          f32x4 v0 = acc[ai][bj][m][0], v1 = acc[ai][bj][m][1];
          v0[0] *= bflo(ga.x) * __builtin_amdgcn_rcpf(bflo(gb.x)); v0[1] *= bfhi(ga.x) * __builtin_amdgcn_rcpf(bfhi(gb.x)); v0[2] *= bflo(ga.y) * __builtin_amdgcn_rcpf(bflo(gb.y)); v0[3] *= bfhi(ga.y) * __builtin_amdgcn_rcpf(bfhi(gb.y));
          v1[0] *= bflo(ga.z) * __builtin_amdgcn_rcpf(bflo(gb.z)); v1[1] *= bfhi(ga.z) * __builtin_amdgcn_rcpf(bfhi(gb.z)); v1[2] *= bflo(ga.w) * __builtin_amdgcn_rcpf(bflo(gb.w)); v1[3] *= bfhi(ga.w) * __builtin_amdgcn_rcpf(bfhi(gb.w));
          acc[ai][bj][m][0] = v0; acc[ai][bj][m][1] = v1; }
        asm volatile("" : "+v"(acc[ai][0][m][0]), "+v"(acc[ai][0][m][1]), "+v"(acc[ai][1][m][0]), "+v"(acc[ai][1][m][1]) :: "memory"); }
    } else {
      UNR for (int ai = 0; ai < 2; ++ai) UNR for (int m = 0; m < 4; ++m) { const size_t ro = (size_t)(pm * 256 + ROW_(ai, m));
        UNR for (int bj = 0; bj < 2; ++bj) { const u32x4 gb = *(const u32x4*)(P4a + gate_off(pm, 8 + pn, wid_, ai, m, bj, lane_));
          const f32x4 v0 = acc[ai][bj][m][0], v1 = acc[ai][bj][m][1]; u32x4 w;
          w.x = pk_bf16(v0[0] * bflo(gb.x), v0[1] * bfhi(gb.x)); w.y = pk_bf16(v0[2] * bflo(gb.y), v0[3] * bfhi(gb.y));
          w.z = pk_bf16(v1[0] * bflo(gb.z), v1[1] * bfhi(gb.z)); w.w = pk_bf16(v1[2] * bflo(gb.w), v1[3] * bfhi(gb.w));
          *(u32x4*)(MG + ro * DM + pn * 256 + COLP_(bj)) = w; }
        asm volatile("" ::: "memory"); }
    }
  });
}

DEV void phase_gm(const Params& p, char* lds) {
  const u16* H = (const u16*)(p.ws + OFF_H); const u16* WG = (const u16*)(p.ws + OFF_WG);
  const u16* AA = (const u16*)(p.ws + OFF_AA); const u16* AM = (const u16*)(p.ws + OFF_AM);
  const u16* WA = (const u16*)(p.ws + OFF_WPA); const u16* WM = (const u16*)(p.ws + OFF_WPM);
  u16* P4 = (u16*)(p.ws + OFF_P4); u16* MG = (u16*)(p.ws + OFF_MG);
  gemm_stream_gm(H, WG, AA, AM, WA, WM, 64, 8, (lchar*)lds, [=](f32x4 (&acc)[2][2][4][2], int pm, int pn, int q, int wr, int wc) {
    RELANE; u16* P4a = launder(P4); const int wid_ = wr * 4 + wc, lane_ = fq * 16 + fr;
    if (q < 2) {
      UNR for (int ai = 0; ai < 2; ++ai) UNR for (int m = 0; m < 4; ++m) {
        UNR for (int bj = 0; bj < 2; ++bj) { const f32x4 v0 = acc[ai][bj][m][0], v1 = acc[ai][bj][m][1]; u32x4 w;
          w.x = pk_bf16(sigmoidf_(v0[0]), sigmoidf_(v0[1])); w.y = pk_bf16(sigmoidf_(v0[2]), sigmoidf_(v0[3]));
          w.z = pk_bf16(sigmoidf_(v1[0]), sigmoidf_(v1[1])); w.w = pk_bf16(sigmoidf_(v1[2]), sigmoidf_(v1[3]));
          *(u32x4*)(P4a + gate_off(pm, q * 8 + pn, wid_, ai, m, bj, lane_)) = w; } }
    } else if (q == 2) {
      UNR for (int ai = 0; ai < 2; ++ai) UNR for (int m = 0; m < 4; ++m) {
        UNR for (int bj = 0; bj < 2; ++bj) { const u32x4 ga = *(const u32x4*)(P4a + gate_off(pm, pn, wid_, ai, m, bj, lane_)), gb = *(const u32x4*)(P4a + gate_off(pm, 8 + pn, wid_, ai, m, bj, lane_));
          f32x4 v0 = acc[ai][bj][m][0], v1 = acc[ai][bj][m][1];
          v0[0] *= bflo(ga.x) * __builtin_amdgcn_rcpf(bflo(gb.x)); v0[1] *= bfhi(ga.x) * __builtin_amdgcn_rcpf(bfhi(gb.x)); v0[2] *= bflo(ga.y) * __builtin_amdgcn_rcpf(bflo(gb.y)); v0[3] *= bfhi(ga.y) * __builtin_amdgcn_rcpf(bfhi(gb.y));
          v1[0] *= bflo(ga.z) * __builtin_amdgcn_rcpf(bflo(gb.z)); v1[1] *= bfhi(ga.z) * __builtin_amdgcn_rcpf(bfhi(gb.z)); v1[2] *= bflo(ga.w) * __builtin_amdgcn_rcpf(bflo(gb.w)); v1[3] *= bfhi(ga.w) * __builtin_amdgcn_rcpf(bfhi(gb.w));
          acc[ai][bj][m][0] = v0; acc[ai][bj][m][1] = v1; }
        asm volatile("" : "+v"(acc[ai][0][m][0]), "+v"(acc[ai][0][m][1]), "+v"(acc[ai][1][m][0]), "+v"(acc[ai][1][m][1]) :: "memory"); }
    } else {
      UNR for (int ai = 0; ai < 2; ++ai) UNR for (int m = 0; m < 4; ++m) { const size_t ro = (size_t)(pm * 256 + ROW_(ai, m));
        UNR for (int bj = 0; bj < 2; ++bj) { const u32x4 gb = *(const u32x4*)(P4a + gate_off(pm, 8 + pn, wid_, ai, m, bj, lane_));
          const f32x4 v0 = acc[ai][bj][m][0], v1 = acc[ai][bj][m][1]; u32x4 w;
          w.x = pk_bf16(v0[0] * bflo(gb.x), v0[1] * bfhi(gb.x)); w.y = pk_bf16(v0[2] * bflo(gb.y), v0[3] * bfhi(gb.y));
          w.z = pk_bf16(v1[0] * bflo(gb.z), v1[1] * bfhi(gb.z)); w.w = pk_bf16(v1[2] * bflo(gb.w), v1[3] * bfhi(gb.w));
          *(u32x4*)(MG + ro * DM + pn * 256 + COLP_(bj)) = w; }
        asm volatile("" ::: "memory"); }
    }
  });
}

DEV void phase_gemm_out(const Params& p, char* lds) {
  const u16* MG = (const u16*)(p.ws + OFF_MG); const u16* WO = (const u16*)(p.ws + OFF_WOUT);
  const float* mod = (const float*)(p.ws + OFF_MOD); u16* DL = (u16*)(p.ws + OFF_DL);
  gemm_stream(MG, DM, WO, DM, DM, 64, 8, (lchar*)lds, [=](const f32x4 (&acc)[2][2][4][2], int pm, int pn, int wr, int wc, int fr, int fq) {
    const int b = (pm * 256) / SEQ;
    UNR for (int bj = 0; bj < 2; ++bj) { const int c0 = pn * 256 + COLP_(bj);
      const f32x4 g0 = *(const f32x4*)(mod + b * 6144 + 4096 + c0), g1 = *(const f32x4*)(mod + b * 6144 + 4096 + c0 + 4);
      UNR for (int ai = 0; ai < 2; ++ai) UNR for (int m = 0; m < 4; ++m) { const size_t ro = (size_t)(pm * 256 + ROW_(ai, m)) * DM + c0;
        const f32x4 v0 = g0 * acc[ai][bj][m][0], v1 = g1 * acc[ai][bj][m][1]; u32x4 w;
        w.x = pk_bf16(v0[0], v0[1]); w.y = pk_bf16(v0[2], v0[3]); w.z = pk_bf16(v1[0], v1[1]); w.w = pk_bf16(v1[2], v1[3]);
        *(u32x4*)(DL + ro) = w; } }
  });
}

DEV void phase_final(const Params& p) {
  const int wid = ltid() >> 6, lane = ltid() & 63;
  const u16* DL = (const u16*)(p.ws + OFF_DL);
#pragma unroll 1
  for (int row = (blockIdx.x * 8 + wid) * 2; row < NTOK; row += gridDim.x * 16) {
    const size_t ro = (size_t)row * DM + lane * 4;
    f32x4 xv[8], yv[8]; u32x2 dx[8], dy[8]; float ss = 0.f, st = 0.f;
    UNR for (int i = 0; i < 8; ++i) { xv[i] = *(const f32x4*)(p.x + ro + 256 * i); yv[i] = *(const f32x4*)(p.x + ro + DM + 256 * i);
      dx[i] = *(const u32x2*)(DL + ro + 256 * i); dy[i] = *(const u32x2*)(DL + ro + DM + 256 * i); }
    UNR for (int i = 0; i < 8; ++i) {
      xv[i][0] += bflo(dx[i].x); xv[i][1] += bfhi(dx[i].x); xv[i][2] += bflo(dx[i].y); xv[i][3] += bfhi(dx[i].y);
      yv[i][0] += bflo(dy[i].x); yv[i][1] += bfhi(dy[i].x); yv[i][2] += bflo(dy[i].y); yv[i][3] += bfhi(dy[i].y);
      ss += xv[i][0] * xv[i][0] + xv[i][1] * xv[i][1] + xv[i][2] * xv[i][2] + xv[i][3] * xv[i][3];
      st += yv[i][0] * yv[i][0] + yv[i][1] * yv[i][1] + yv[i][2] * yv[i][2] + yv[i][3] * yv[i][3]; }
    ss = wave_sum(ss); st = wave_sum(st);
    const float r0 = rsqrtf(ss * (1.0f / 2048.0f) + 1e-6f), r1 = rsqrtf(st * (1.0f / 2048.0f) + 1e-6f);
    UNR for (int i = 0; i < 8; ++i) { const f32x4 g = *(const f32x4*)(p.fgain + lane * 4 + 256 * i); *(f32x4*)(p.out + ro + 256 * i) = xv[i] * r0 * g; *(f32x4*)(p.out + ro + DM + 256 * i) = yv[i] * r1 * g; }
  }
}


#define XB_TMO      128
#define XB_XCNT(j)  (256  + 64 * (j))
#define XB_XSUB(j)  (1280 + 64 * (j))
#define XB_XGEN(j)  (2304 + 64 * (j))
#define XB_TOP      3328
#define XB_TOPGEN   3392
#define XCD_BAR_WORDS 3456
#define XB_SPIN_CAP (1u << 20)
DEV unsigned xb_ld(unsigned* p)              { return __hip_atomic_load(p, __ATOMIC_RELAXED, __HIP_MEMORY_SCOPE_AGENT); }
DEV unsigned xb_add(unsigned* p, unsigned v) { return __hip_atomic_fetch_add(p, v, __ATOMIC_RELAXED, __HIP_MEMORY_SCOPE_AGENT); }
DEV unsigned xb_xcc_id() { return (unsigned)__builtin_amdgcn_s_getreg((3 << 11) | 20) & 0xFu; }
#define XB_SPIN(cond, bar) do { unsigned _sp = 0; while (cond) { __builtin_amdgcn_s_sleep(1); \
    if ((++_sp & 255u) == 0u) { if (xb_ld(&(bar)[XB_TMO])) break; if (_sp > XB_SPIN_CAP) { atomicAdd(&(bar)[XB_TMO], 1u); break; } } } } while (0)
struct XcdBarrier { unsigned* bar; unsigned x; volatile LAS unsigned* st; };
DEV XcdBarrier xcd_barrier_post(unsigned* bar, volatile LAS unsigned* st) {
  XcdBarrier b; b.bar = bar; b.x = xb_xcc_id(); b.st = st;
  if (threadIdx_x_raw() == 0) (void)xb_add(&bar[XB_XCNT(b.x)], 1u);
  return b;
}
DEV void xcd_barrier_complete(unsigned* bar, unsigned x, unsigned& nloc, unsigned& nx) {
  const unsigned G = gridDim.x;
  unsigned sum, cnt, mine, sp = 0u;
  for (;;) {
    sum = 0u; cnt = 0u; mine = 0u;
#pragma unroll
    for (unsigned j = 0; j < 16; ++j) { const unsigned c = xb_ld(&bar[XB_XCNT(j)]); sum += c; cnt += (c > 0u) ? 1u : 0u; mine = (j == x) ? c : mine; }
    if (sum == G) break;
    __builtin_amdgcn_s_sleep(1);
    if ((++sp & 255u) == 0u) { if (xb_ld(&bar[XB_TMO])) break; if (sp > XB_SPIN_CAP) { atomicAdd(&bar[XB_TMO], 1u); break; } }
  }
  nloc = mine > 0u ? mine : 1u; nx = cnt > 0u ? cnt : 1u;
}
DEV void xcd_barrier(const XcdBarrier& b) {
  asm volatile("s_waitcnt vmcnt(0)" ::: "memory");
  __syncthreads();
  if (threadIdx_x_raw() == 0) {
    unsigned* bar = b.bar;
    __builtin_amdgcn_s_waitcnt(0);
    unsigned nloc = b.st[0], nx = b.st[1];
    if (nloc == 0u) { xcd_barrier_complete(bar, b.x, nloc, nx); b.st[0] = nloc; b.st[1] = nx; }
    const unsigned old = xb_add(&bar[XB_XSUB(b.x)], 1u);
    const unsigned gen = old / nloc;
    if (old + 1u == (gen + 1u) * nloc) {
      __builtin_amdgcn_fence(__ATOMIC_RELEASE, "agent");
      asm volatile("s_waitcnt vmcnt(0)" ::: "memory");
      const unsigned og = xb_add(&bar[XB_TOP], 1u);
      const unsigned tg = og / nx;
      if (og + 1u == (tg + 1u) * nx) xb_add(&bar[XB_TOPGEN], 1u);
      else XB_SPIN(xb_ld(&bar[XB_TOPGEN]) == tg, bar);
      __builtin_amdgcn_fence(__ATOMIC_ACQUIRE, "agent");
      xb_add(&bar[XB_XGEN(b.x)], 1u);
      asm volatile("s_waitcnt vmcnt(0)" ::: "memory");
    } else {
      XB_SPIN(xb_ld(&bar[XB_XGEN(b.x)]) == gen, bar);
      __builtin_amdgcn_fence(__ATOMIC_ACQUIRE, "agent");
      asm volatile("s_waitcnt vmcnt(0)" ::: "memory");
    }
  }
  __syncthreads();
}

constexpr int NPHASE = 11;
#ifndef ONE_LAUNCH
#define ONE_LAUNCH 1
#endif
#if ONE_LAUNCH
__global__ void __launch_bounds__(NTHR, 2) mega(Params p) {
  extern __shared__ __attribute__((aligned(16))) char lds[];
  cg::grid_group grid = cg::this_grid();
  volatile LAS unsigned* st = (volatile LAS unsigned*)((lchar*)lds + OFF_LDS_ST);
  if (threadIdx_x_raw() == 0) { st[0] = 0u; st[1] = 0u; }
  __syncthreads();
  const XcdBarrier xb = xcd_barrier_post((unsigned*)(p.ws + OFF_BAR), st);
  if (p.ws == nullptr) grid.sync();
  phase_prep(p, lds); xcd_barrier(xb);
  phase_h(p, lds); xcd_barrier(xb);
#if PROBE_DUP == 8
  phase_prep(p, lds); xcd_barrier(xb);
#endif
#if PROBE_DUP == 9
  phase_h(p, lds); xcd_barrier(xb);
#endif
#if PROBE_DUP == 4
  phase_prep(p, lds); xcd_barrier(xb); phase_h(p, lds); xcd_barrier(xb);
#endif
  phase_gemm_main(p, lds); xcd_barrier(xb);
#if PROBE_DUP == 1
  phase_gemm_main(p, lds); xcd_barrier(xb);
#endif
  phase_d1(p, lds); xcd_barrier(xb);
#if PROBE_DUP == 2
  phase_d1(p, lds); xcd_barrier(xb);
#endif
  phase_scan(p, lds); xcd_barrier(xb);
  phase_d4(p, lds); xcd_barrier(xb);
#if PROBE_DUP == 11
  phase_scan(p, lds); xcd_barrier(xb);
#endif
#if PROBE_DUP == 12
  phase_d4(p, lds); xcd_barrier(xb);
#endif
#if PROBE_DUP == 3
  phase_scan(p, lds); xcd_barrier(xb); phase_d4(p, lds); xcd_barrier(xb);
#endif
#if USE_GM
  phase_gm(p, lds); xcd_barrier(xb);
#else
  phase_gemm_gates(p, lds); xcd_barrier(xb);
#if PROBE_DUP == 5
  phase_gemm_gates(p, lds); xcd_barrier(xb);
#endif
  phase_gemm_merge(p, lds); xcd_barrier(xb);
#endif
#if PROBE_DUP == 6
  phase_gemm_merge(p, lds); xcd_barrier(xb);
#endif
  phase_gemm_out(p, lds); xcd_barrier(xb);
#if PROBE_DUP == 7
  phase_gemm_out(p, lds); xcd_barrier(xb);
#endif
  phase_final(p);
#if PROBE_DUP == 24
  xcd_barrier(xb); phase_final(p);
#endif
}
#define MEGA_FN mega
static void setattr_all() {}
#else
template <int PH> __global__ void __launch_bounds__(NTHR, 2) phk(Params p) {
  extern __shared__ __attribute__((aligned(16))) char lds[];
  if (PH == 0) phase_prep(p, lds);
  if (PH == 1) phase_h(p, lds);
  if (PH == 2) phase_gemm_main(p, lds);
  if (PH == 3) phase_d1(p, lds);
  if (PH == 4) { }
  if (PH == 5) phase_scan(p, lds);
  if (PH == 6) phase_d4(p, lds);
  if (PH == 7) phase_gemm_gates(p, lds);
  if (PH == 8) phase_gemm_merge(p, lds);
  if (PH == 9) phase_gemm_out(p, lds);
  if (PH == 10) phase_final(p);
}
#define MEGA_FN phk<2>
template <int PH> static void setattr_ph() { (void)hipFuncSetAttribute((const void*)phk<PH>, hipFuncAttributeMaxDynamicSharedMemorySize, LDS_BYTES); }
static void setattr_all() { setattr_ph<0>(); setattr_ph<1>(); setattr_ph<2>(); setattr_ph<3>(); setattr_ph<4>(); setattr_ph<5>(); setattr_ph<6>(); setattr_ph<7>(); setattr_ph<8>(); setattr_ph<9>(); setattr_ph<10>(); }
template <int PH> static void launch_ph(const Params& p, int grid, hipStream_t stream) {
  phk<PH><<<dim3(grid), dim3(NTHR), LDS_BYTES, stream>>>(p);
}
#endif

extern "C" void kernel_launch(void* const* d_in, const int* in_sizes, int n_in, void* d_out, int out_size, void* d_ws, size_t ws_size, hipStream_t stream) {
  static int grid = 0;
  if (!grid) {
    if (ws_size < WS_NEED || out_size != NTOK * DM || n_in != 14) { fprintf(stderr, "kernel_launch: unexpected sizes (ws %zu need %zu)\n", ws_size, (size_t)WS_NEED); grid = -1; return; }
    int dev = 0, cus = 0, per_cu = 0;
    (void)hipGetDevice(&dev); (void)hipDeviceGetAttribute(&cus, hipDeviceAttributeMultiprocessorCount, dev);
    (void)hipFuncSetAttribute((const void*)MEGA_FN, hipFuncAttributeMaxDynamicSharedMemorySize, LDS_BYTES); setattr_all();
    (void)hipOccupancyMaxActiveBlocksPerMultiprocessor(&per_cu, (const void*)MEGA_FN, NTHR, LDS_BYTES);
    if (per_cu < 1) { fprintf(stderr, "kernel_launch: occupancy query says 0 blocks per CU\n"); grid = -1; return; }
    grid = cus;
  }
  if (grid < 0) return;
  Params p{};
  p.x = (const float*)d_in[0]; p.c = (const float*)d_in[1]; p.norm_gain = (const float*)d_in[2]; p.w_ada = (const float*)d_in[3]; p.b_ada = (const float*)d_in[4];
  p.w_in = (const float*)d_in[5]; p.b_gate_if = (const float*)d_in[6]; p.conv_w = (const float*)d_in[7]; p.conv_b = (const float*)d_in[8]; p.mgain = (const float*)d_in[9];
  p.w_pa = (const float*)d_in[10]; p.w_pm = (const float*)d_in[11]; p.w_out = (const float*)d_in[12]; p.fgain = (const float*)d_in[13];
  p.out = (float*)d_out; p.ws = (char*)d_ws;
#if ONE_LAUNCH
  (void)hipMemsetAsync((char*)d_ws + OFF_BAR, 0, XCD_BAR_WORDS * 4, stream);
  void* args[] = {&p};
  hipError_t e = hipLaunchCooperativeKernel((const void*)mega, dim3(grid), dim3(NTHR), args, LDS_BYTES, stream);
  if (e != hipSuccess) fprintf(stderr, "cooperative launch failed: %s\n", hipGetErrorString(e));
#else
  launch_ph<0>(p, grid, stream); launch_ph<1>(p, grid, stream); launch_ph<2>(p, grid, stream); launch_ph<3>(p, grid, stream);
  launch_ph<4>(p, grid, stream); launch_ph<5>(p, grid, stream); launch_ph<6>(p, grid, stream); launch_ph<7>(p, grid, stream);
  launch_ph<8>(p, grid, stream); launch_ph<9>(p, grid, stream); launch_ph<10>(p, grid, stream);
#endif
}
```

```cpp
#include <hip/hip_runtime.h>
#include <hip/hip_cooperative_groups.h>
#include <cstdio>
#include <cstdint>
namespace cg = cooperative_groups;

typedef unsigned short u16;
typedef short bf16x8 __attribute__((ext_vector_type(8)));
typedef float f32x4 __attribute__((ext_vector_type(4)));
typedef unsigned u32x4 __attribute__((ext_vector_type(4)));
typedef unsigned u32x2 __attribute__((ext_vector_type(2)));

#define PROBE_DUP 0
#define USE_GM 1
#define DEV __device__ __forceinline__
__device__ __forceinline__ int threadIdx_x_raw() { return (int)threadIdx.x; }
DEV int ltid() { int t = threadIdx_x_raw(); asm volatile("" : "+v"(t)); return t; }
#define UNR _Pragma("unroll")
#define RELANE int l_ = ltid() & 63; asm volatile("" : "+v"(l_)); const int fr = l_ & 15, fq = l_ >> 4; (void)fr; (void)fq
template <class T> __device__ __forceinline__ T* launder(T* p) { asm volatile("" : "+s"(p)); return p; }

constexpr int NTOK = 16384, DM = 2048, SEQ = 8192, INC = 13320;
constexpr int NTHR = 512;
constexpr int LDS_BYTES = 159744;
constexpr size_t MBy = 1ull << 20;
constexpr size_t OFF_MODP = 576 * 1024;
constexpr size_t OFF_MOD = 0, OFF_BAR = 49152, OFF_IFG = 64 * 1024, OFF_LSE = 1 * MBy;
constexpr int OFF_LDS_ST = 159488;
constexpr size_t OFF_SA = 2 * MBy + 512 * 1024, OFF_SC = OFF_SA + 256 * 1024, OFF_SCM = OFF_SC + 256 * 1024;
constexpr size_t OFF_IA = 3 * MBy + 256 * 1024, OFF_IG = OFF_IA + 4096, OFF_MK = OFF_IG + 4096;
constexpr size_t OFF_NU = 3 * MBy + 512 * 1024, OFF_NK = OFF_NU + 256 * 1024;
constexpr size_t OFF_WPA = 4 * MBy, OFF_WPM = 8 * MBy, OFF_WOUT = 12 * MBy, OFF_WG = 20 * MBy, OFF_WMAIN = 36 * MBy;
constexpr size_t OFF_H = 72 * MBy, OFF_P3 = 136 * MBy, OFF_P1 = 232 * MBy, OFF_P2 = 328 * MBy;
constexpr size_t OFF_QC = 424 * MBy, OFF_KC = 456 * MBy, WS_NEED = 488 * MBy;
constexpr size_t OFF_KWT = OFF_WMAIN;
constexpr size_t OFF_U = 232 * MBy, OFF_CT = 296 * MBy, OFF_PB = 328 * MBy, OFF_AA = 360 * MBy, OFF_AM = 392 * MBy;
constexpr size_t OFF_P4 = 232 * MBy;
constexpr size_t OFF_MG = 424 * MBy;
constexpr size_t OFF_DL = 360 * MBy;
constexpr size_t DO_OATT = 0, DO_VT = 96 * MBy;

struct Params {
  const float *x, *c, *norm_gain, *w_ada, *b_ada, *w_in, *b_gate_if, *conv_w, *conv_b, *mgain, *w_pa, *w_pm, *w_out, *fgain;
  float* out; char* ws;
};

DEV float bf2f(u16 v) { return __uint_as_float(((unsigned)v) << 16); }
DEV float bflo(unsigned u) { return __uint_as_float(u << 16); }
DEV float bfhi(unsigned u) { return __uint_as_float(u & 0xffff0000u); }
typedef float f32x2_ __attribute__((ext_vector_type(2)));
typedef __bf16 bf16x2_ __attribute__((ext_vector_type(2)));
DEV unsigned pk_bf16(float lo, float hi) { f32x2_ v = {lo, hi}; bf16x2_ b = __builtin_convertvector(v, bf16x2_); return __builtin_bit_cast(unsigned, b); }
DEV float sigmoidf_(float v) { return __builtin_amdgcn_rcpf(1.0f + __expf(-v)); }
DEV float siluf_(float v) { return v * __builtin_amdgcn_rcpf(1.0f + __expf(-v)); }
DEV float wave_sum(float v) {
  v += __int_as_float(__builtin_amdgcn_update_dpp(0, __float_as_int(v), 0xB1, 0xf, 0xf, true));
  v += __int_as_float(__builtin_amdgcn_update_dpp(0, __float_as_int(v), 0x4E, 0xf, 0xf, true));
  v += __int_as_float(__builtin_amdgcn_update_dpp(0, __float_as_int(v), 0x141, 0xf, 0xf, true));
  v += __int_as_float(__builtin_amdgcn_update_dpp(0, __float_as_int(v), 0x140, 0xf, 0xf, true));
  return __int_as_float(__builtin_amdgcn_readlane(__float_as_int(v), 0)) + __int_as_float(__builtin_amdgcn_readlane(__float_as_int(v), 16)) +
         __int_as_float(__builtin_amdgcn_readlane(__float_as_int(v), 32)) + __int_as_float(__builtin_amdgcn_readlane(__float_as_int(v), 48));
}
DEV int perm32(int rho) { const int n = rho >> 4, i = rho & 15; return 8 * (i >> 2) + 4 * n + (i & 3); }

constexpr int BK = 64, HALF = 128, HT = HALF * BK;
DEV int lds_byte(int r, int c) { int st = (r >> 4) * 2 + (c >> 5), rr = r & 15, cc = c & 31, ob = rr * 64 + cc * 2; return st * 1024 + (ob ^ (((ob >> 9) & 1) << 5)); }
DEV void stage_rc(int b, int& R, int& C) { int st = b / 1024, sb = b % 1024, swz = sb ^ (((sb >> 9) & 1) << 5); R = (st >> 1) * 16 + swz / 64; C = (st & 1) * 32 + (swz % 64) / 2; }

#define LAS __attribute__((address_space(3)))
typedef LAS char lchar;
constexpr int HTB = HT * 2;
#define SA_(b, h) (((b) * 2 + (h)) * HTB)
#define SB_(b, h) ((4 + (b) * 2 + (h)) * HTB)
#define STAGE(bufoff, gbase, voff) do { _Pragma("unroll") for (int _i = 0; _i < 2; ++_i) \
    __builtin_amdgcn_global_load_lds((const unsigned*)((const char*)(gbase) + (voff)[_i]), (LAS unsigned*)(lds + (bufoff) + ldsw + _i * 8192), 16, 0, 0); } while (0)
#define LDA(dst, b, h) do { _Pragma("unroll") for (int m = 0; m < 4; ++m) _Pragma("unroll") for (int k = 0; k < 2; ++k) dst[m][k] = *(const LAS bf16x8*)(lds + SA_(b, h) + aoff + m * 2048 + k * 1024); } while (0)
#define LDB(dst, b, h) do { _Pragma("unroll") for (int n = 0; n < 2; ++n) _Pragma("unroll") for (int k = 0; k < 2; ++k) dst[n][k] = *(const LAS bf16x8*)(lds + SB_(b, h) + boff + n * 2048 + k * 1024); } while (0)
#define MMA(ai, bj, At, Bx) do { __builtin_amdgcn_s_setprio(1); _Pragma("unroll") for (int m = 0; m < 4; ++m) _Pragma("unroll") for (int n = 0; n < 2; ++n) _Pragma("unroll") for (int k = 0; k < 2; ++k) \
      acc[ai][bj][m][n] = __builtin_amdgcn_mfma_f32_16x16x32_bf16(Bx[n][k], At[m][k], acc[ai][bj][m][n], 0, 0, 0); \
    __builtin_amdgcn_s_setprio(0); } while (0)
#define WAIT_V(n) asm volatile("s_waitcnt vmcnt(" #n ")" ::: "memory")
#define WAIT_L(n) asm volatile("s_waitcnt lgkmcnt(" #n ")" ::: "memory")
#define BAR __builtin_amdgcn_s_barrier()
#define SCHED __builtin_amdgcn_sched_barrier(0)

DEV void gemm_kloop(f32x4 (&acc)[2][2][4][2], const u16* A, int lda, const u16* Bt, int ldb, int K, lchar* lds) {
  const int tid = ltid(), wid = __builtin_amdgcn_readfirstlane(tid >> 6), lane = tid & 63, wr = wid >> 2, wc = wid & 3, fr = lane & 15, fq = lane >> 4;
  unsigned voffA[2], voffB[2];
#pragma unroll
  for (int i = 0; i < 2; ++i) { int R, C; stage_rc(tid * 16 + i * 8192, R, C); const int Rb = (R & ~31) + perm32(R & 31); voffA[i] = (unsigned)(R * lda + C) * 2u; voffB[i] = (unsigned)(Rb * ldb + C) * 2u; }
  const size_t kstep = (size_t)(BK * 2), hA = (size_t)HALF * lda * 2, hB = (size_t)HALF * ldb * 2;
  const unsigned ldsw = (unsigned)wid * 1024u;
  const int aoff = lds_byte(wr * 64 + fr, fq * 8), boff = lds_byte(wc * 32 + fr, fq * 8);
  const char* cA = (const char*)A; const char* cB = (const char*)Bt;
  bf16x8 At[4][2], B0[2][2], B1[2][2];
  const int nt = K / BK;
  STAGE(SB_(0, 0), cB, voffB); STAGE(SA_(0, 0), cA, voffA); STAGE(SB_(0, 1), cB + hB, voffB); STAGE(SA_(0, 1), cA + hA, voffA);
  if (wr == 1) BAR;
  WAIT_V(4); BAR;
  STAGE(SB_(1, 0), cB + kstep, voffB); STAGE(SA_(1, 0), cA + kstep, voffA); STAGE(SB_(1, 1), cB + hB + kstep, voffB);
  WAIT_V(6); BAR;
  for (int t = 0; t < nt - 2; t += 2) {
    const char* a1 = cA + (size_t)(t + 1) * kstep; const char* a2 = a1 + kstep; const char* a3 = a2 + kstep;
    const char* b2 = cB + (size_t)(t + 2) * kstep; const char* b3 = b2 + kstep;
    LDB(B0, 0, 0); SCHED; LDA(At, 0, 0); STAGE(SA_(1, 1), a1 + hA, voffA);
    WAIT_L(8); BAR; WAIT_L(0); MMA(0, 0, At, B0); BAR; SCHED;
    LDB(B1, 0, 1); STAGE(SB_(0, 0), b2, voffB);
    BAR; WAIT_L(0); MMA(0, 1, At, B1); BAR;
    LDA(At, 0, 1); STAGE(SA_(0, 0), a2, voffA);
    BAR; WAIT_L(0); MMA(1, 0, At, B0); BAR; SCHED;
    STAGE(SB_(0, 1), b2 + hB, voffB);
    WAIT_V(6); BAR; MMA(1, 1, At, B1); BAR;
    LDB(B0, 1, 0); SCHED; LDA(At, 1, 0); STAGE(SA_(0, 1), a2 + hA, voffA);
    WAIT_L(8); BAR; WAIT_L(0); MMA(0, 0, At, B0); BAR; SCHED;
    LDB(B1, 1, 1); STAGE(SB_(1, 0), b3, voffB);
    BAR; WAIT_L(0); MMA(0, 1, At, B1); BAR;
    LDA(At, 1, 1); STAGE(SA_(1, 0), a3, voffA);
    BAR; WAIT_L(0); MMA(1, 0, At, B0); BAR; SCHED;
    STAGE(SB_(1, 1), b3 + hB, voffB);
    WAIT_V(6); BAR; MMA(1, 1, At, B1); BAR;
  }
  { LDB(B0, 0, 0); LDA(At, 0, 0); STAGE(SA_(1, 1), cA + (size_t)(nt - 1) * kstep + hA, voffA);
    BAR; WAIT_L(0); MMA(0, 0, At, B0); BAR;
    LDB(B1, 0, 1); BAR; WAIT_L(0); MMA(0, 1, At, B1); BAR;
    LDA(At, 0, 1); WAIT_V(4); BAR; WAIT_L(0); MMA(1, 0, At, B0); MMA(1, 1, At, B1); BAR; }
  { LDB(B0, 1, 0); LDA(At, 1, 0); WAIT_V(2); BAR; WAIT_L(0); MMA(0, 0, At, B0); BAR;
    LDB(B1, 1, 1); WAIT_V(0); BAR; WAIT_L(0); MMA(0, 1, At, B1); BAR;
    LDA(At, 1, 1); BAR; WAIT_L(0); MMA(1, 0, At, B0); MMA(1, 1, At, B1); BAR; }
  if (wr == 0) BAR;
}

DEV void acc_zero(f32x4 (&acc)[2][2][4][2]) {
  _Pragma("unroll") for (int a = 0; a < 2; ++a) _Pragma("unroll") for (int b = 0; b < 2; ++b) _Pragma("unroll") for (int m = 0; m < 4; ++m) _Pragma("unroll") for (int n = 0; n < 2; ++n) acc[a][b][m][n] = (f32x4){0.f, 0.f, 0.f, 0.f};
}
DEV bool tile_next(int i, int nM, int nN, int& pm, int& pn) {
  const int nwg = nM * nN; const long L = (long)i * gridDim.x + blockIdx.x; if (L >= nwg) return false;
  int wgid = (int)L; { const int q = nwg / 8, r = nwg % 8, xcd = wgid % 8, off = wgid / 8; wgid = (xcd < r ? xcd * (q + 1) : r * (q + 1) + (xcd - r) * q) + off; }
  const int nig = 8 * nN, gid = wgid / nig, fm = gid * 8, gsz = (nM - fm) < 8 ? (nM - fm) : 8;
  pm = fm + ((wgid % nig) % gsz); pn = (wgid % nig) / gsz; return true;
}
template <class Epi>
DEV void gemm_stream(const u16* A, int lda, const u16* Bt, int ldb, int K, int nM, int nN, lchar* lds, Epi&& epi) {
  const int tid = ltid(), wid = __builtin_amdgcn_readfirstlane(tid >> 6), lane = tid & 63, wr = wid >> 2, wc = wid & 3, fr = lane & 15, fq = lane >> 4;
  int pm, pn, npm, npn, ui = 0;
  if (!tile_next(0, nM, nN, pm, pn)) return;
  unsigned voffA[2], voffB[2];
#pragma unroll
  for (int i = 0; i < 2; ++i) { int R, C; stage_rc(tid * 16 + i * 8192, R, C); voffA[i] = (unsigned)(R * lda + C) * 2u; voffB[i] = (unsigned)(R * ldb + C) * 2u; }
  const size_t kstep = (size_t)(BK * 2), hA = (size_t)HALF * lda * 2, hB = (size_t)HALF * ldb * 2, tA = 2 * hA, tB = 2 * hB;
  const unsigned ldsw = (unsigned)wid * 1024u;
  const int aoff = lds_byte(wr * 64 + fr, fq * 8), boff = lds_byte(wc * 32 + fr, fq * 8);
  const int nt = K / BK;
  f32x4 acc[2][2][4][2]; acc_zero(acc);
  bf16x8 At[4][2], B0[2][2], B1[2][2];
  const char* cA = (const char*)A + (size_t)pm * tA; const char* cB = (const char*)Bt + (size_t)pn * tB;
  STAGE(SB_(0, 0), cB, voffB); STAGE(SB_(0, 1), cB + hB, voffB); STAGE(SA_(0, 0), cA, voffA); STAGE(SA_(0, 1), cA + hA, voffA);
  if (wr == 1) BAR;
  WAIT_V(2); BAR;
  STAGE(SB_(1, 0), cB + kstep, voffB); STAGE(SA_(1, 0), cA + kstep, voffA); STAGE(SB_(1, 1), cB + hB + kstep, voffB);
  WAIT_V(6); BAR;
  for (;;) {
    const bool has_next = tile_next(ui + 1, nM, nN, npm, npn);
    const char* nA = has_next ? (const char*)A + (size_t)npm * tA : cA; const char* nB = has_next ? (const char*)Bt + (size_t)npn * tB : cB;
    for (int t = 0; t < nt; t += 2) {
      const bool last = (t == nt - 2);
      const char* a1 = cA + (size_t)(t + 1) * kstep;
      const char* a2 = last ? nA : cA + (size_t)(t + 2) * kstep; const char* b2 = last ? nB : cB + (size_t)(t + 2) * kstep;
      const char* a3 = a2 + kstep; const char* b3 = b2 + kstep;
      LDB(B0, 0, 0); LDB(B1, 0, 1); SCHED; LDA(At, 0, 0); STAGE(SA_(1, 1), a1 + hA, voffA);
      WAIT_V(8); WAIT_L(0); BAR; MMA(0, 0, At, B0); MMA(0, 1, At, B1); BAR; SCHED;
      LDA(At, 0, 1); STAGE(SB_(0, 0), b2, voffB); STAGE(SB_(0, 1), b2 + hB, voffB); STAGE(SA_(0, 0), a2, voffA);
      WAIT_V(8); WAIT_L(0); BAR; MMA(1, 0, At, B0); MMA(1, 1, At, B1); BAR; SCHED;
      LDB(B0, 1, 0); LDB(B1, 1, 1); SCHED; LDA(At, 1, 0); STAGE(SA_(0, 1), a2 + hA, voffA);
      WAIT_V(8); WAIT_L(0); BAR; MMA(0, 0, At, B0); MMA(0, 1, At, B1); BAR; SCHED;
      LDA(At, 1, 1); STAGE(SB_(1, 0), b3, voffB); STAGE(SB_(1, 1), b3 + hB, voffB); STAGE(SA_(1, 0), a3, voffA);
      WAIT_V(8); WAIT_L(0); BAR; MMA(1, 0, At, B0); MMA(1, 1, At, B1); BAR; SCHED;
    }
    if (wr == 0) BAR;
    epi(acc, pm, pn, wr, wc, fr, fq);
    if (!has_next) break;
    acc_zero(acc);
    pm = npm; pn = npn; cA = nA; cB = nB; ++ui;
    if (wr == 1) BAR;
  }
  WAIT_V(0);
  BAR;
}

template <class Epi>
DEV void gemm_stream2(const u16* A0, const u16* A1, int lda, const u16* B0p, const u16* B1p, int ldb, int K, int nM, int nN, lchar* lds, Epi&& epi) {
  const int tid = ltid(), wid = __builtin_amdgcn_readfirstlane(tid >> 6), lane = tid & 63, wr = wid >> 2, wc = wid & 3, fr = lane & 15, fq = lane >> 4;
  int pm, pn, npm, npn, ui = 0;
  if (!tile_next(0, nM, nN, pm, pn)) return;
  unsigned voffA[2], voffB[2];
#pragma unroll
  for (int i = 0; i < 2; ++i) { int R, C; stage_rc(tid * 16 + i * 8192, R, C); voffA[i] = (unsigned)(R * lda + C) * 2u; voffB[i] = (unsigned)(R * ldb + C) * 2u; }
  const size_t kstep = (size_t)(BK * 2), hA = (size_t)HALF * lda * 2, hB = (size_t)HALF * ldb * 2, tA = 2 * hA, tB = 2 * hB;
  const unsigned ldsw = (unsigned)wid * 1024u;
  const int aoff = lds_byte(wr * 64 + fr, fq * 8), boff = lds_byte(wc * 32 + fr, fq * 8);
  const int nt = K / BK;
  f32x4 acc[2][2][4][2]; acc_zero(acc);
  bf16x8 At[4][2], B0[2][2], B1[2][2];
  const char* cA = (const char*)A0 + (size_t)pm * tA; const char* cB = (const char*)B0p + (size_t)pn * tB;
  STAGE(SB_(0, 0), cB, voffB); STAGE(SB_(0, 1), cB + hB, voffB); STAGE(SA_(0, 0), cA, voffA); STAGE(SA_(0, 1), cA + hA, voffA);
  if (wr == 1) BAR;
  WAIT_V(2); BAR;
  STAGE(SB_(1, 0), cB + kstep, voffB); STAGE(SA_(1, 0), cA + kstep, voffA); STAGE(SB_(1, 1), cB + hB + kstep, voffB);
  WAIT_V(6); BAR;
  for (;;) {
    const int seg = ui & 1;
    bool has_next = true; npm = pm; npn = pn;
    if (seg) has_next = tile_next((ui >> 1) + 1, nM, nN, npm, npn);
    const char* nA = has_next ? (const char*)(seg ? A0 : A1) + (size_t)npm * tA : cA; const char* nB = has_next ? (const char*)(seg ? B0p : B1p) + (size_t)npn * tB : cB;
    for (int t = 0; t < nt; t += 2) {
      const bool last = (t == nt - 2);
      const char* a1 = cA + (size_t)(t + 1) * kstep;
      const char* a2 = last ? nA : cA + (size_t)(t + 2) * kstep; const char* b2 = last ? nB : cB + (size_t)(t + 2) * kstep;
      const char* a3 = a2 + kstep; const char* b3 = b2 + kstep;
      LDB(B0, 0, 0); LDB(B1, 0, 1); SCHED; LDA(At, 0, 0); STAGE(SA_(1, 1), a1 + hA, voffA);
      WAIT_V(8); WAIT_L(0); BAR; MMA(0, 0, At, B0); MMA(0, 1, At, B1); BAR; SCHED;
      LDA(At, 0, 1); STAGE(SB_(0, 0), b2, voffB); STAGE(SB_(0, 1), b2 + hB, voffB); STAGE(SA_(0, 0), a2, voffA);
      WAIT_V(8); WAIT_L(0); BAR; MMA(1, 0, At, B0); MMA(1, 1, At, B1); BAR; SCHED;
      LDB(B0, 1, 0); LDB(B1, 1, 1); SCHED; LDA(At, 1, 0); STAGE(SA_(0, 1), a2 + hA, voffA);
      WAIT_V(8); WAIT_L(0); BAR; MMA(0, 0, At, B0); MMA(0, 1, At, B1); BAR; SCHED;
      LDA(At, 1, 1); STAGE(SB_(1, 0), b3, voffB); STAGE(SB_(1, 1), b3 + hB, voffB); STAGE(SA_(1, 0), a3, voffA);
      WAIT_V(8); WAIT_L(0); BAR; MMA(1, 0, At, B0); MMA(1, 1, At, B1); BAR; SCHED;
    }
    if (wr == 0) BAR;
    epi(acc, pm, pn, seg, wr, wc);
    if (!has_next) break;
    if (seg) acc_zero(acc);
    pm = npm; pn = npn; cA = nA; cB = nB; ++ui;
    if (wr == 1) BAR;
  }
  WAIT_V(0);
  BAR;
}

#define STAGE2(bufoff, gbase, lg) do { \
    __builtin_amdgcn_global_load_lds((const unsigned*)((const char*)(gbase) + ((lg) ? vL0 : vS0)), (LAS unsigned*)(lds + (bufoff) + ldsw), 16, 0, 0); \
    __builtin_amdgcn_global_load_lds((const unsigned*)((const char*)(gbase) + ((lg) ? vL1 : vS1)), (LAS unsigned*)(lds + (bufoff) + ldsw + 8192), 16, 0, 0); } while (0)
template <class Epi>
DEV void gemm_stream_gm(const u16* H, const u16* WG, const u16* AA, const u16* AM, const u16* WA, const u16* WM, int nM, int nN, lchar* lds, Epi&& epi) {
  const int tid = ltid(), wid = __builtin_amdgcn_readfirstlane(tid >> 6), lane = tid & 63, wr = wid >> 2, wc = wid & 3, fr = lane & 15, fq = lane >> 4;
  int pm, pn, npm, npn, ui = 0;
  if (!tile_next(0, nM, nN, pm, pn)) return;
  unsigned vL0, vL1, vS0, vS1;
  { int R, C; stage_rc(tid * 16, R, C); vL0 = (unsigned)(R * 2048 + C) * 2u; vS0 = (unsigned)(R * 1024 + C) * 2u;
    stage_rc(tid * 16 + 8192, R, C); vL1 = (unsigned)(R * 2048 + C) * 2u; vS1 = (unsigned)(R * 1024 + C) * 2u; }
  const size_t kstep = (size_t)(BK * 2), hL = (size_t)HALF * 2048 * 2, hS = (size_t)HALF * 1024 * 2;
  const unsigned ldsw = (unsigned)wid * 1024u;
  const int aoff = lds_byte(wr * 64 + fr, fq * 8), boff = lds_byte(wc * 32 + fr, fq * 8);
  f32x4 acc[2][2][4][2]; acc_zero(acc);
  bf16x8 At[4][2], B0[2][2], B1[2][2];
#define GM_A(q, tpm) ((q) < 2 ? (const char*)H + (size_t)(tpm) * 256 * 2048 * 2 : (const char*)((q) == 2 ? AA : AM) + (size_t)(tpm) * 256 * 1024 * 2)
#define GM_B(q, tpn) ((q) < 2 ? (const char*)WG + ((size_t)(q) * 2048 + (size_t)(tpn) * 256) * 2048 * 2 : (const char*)((q) == 2 ? WA : WM) + (size_t)(tpn) * 256 * 1024 * 2)
  const char* cA = GM_A(0, pm); const char* cB = GM_B(0, pn);
  STAGE2(SB_(0, 0), cB, true); STAGE2(SB_(0, 1), cB + hL, true); STAGE2(SA_(0, 0), cA, true); STAGE2(SA_(0, 1), cA + hL, true);
  if (wr == 1) BAR;
  WAIT_V(2); BAR;
  STAGE2(SB_(1, 0), cB + kstep, true); STAGE2(SA_(1, 0), cA + kstep, true); STAGE2(SB_(1, 1), cB + hL + kstep, true);
  WAIT_V(6); BAR;
  bool has_next = true;
#define GM_UNIT(Q, NA, NB) do { \
    const char* nA = (NA); const char* nB = (NB); \
    constexpr bool cl = (Q) < 2, nl = (((Q) + 1) & 3) < 2; constexpr int nt = cl ? 32 : 16; \
    const size_t ch = cl ? hL : hS; \
    for (int t = 0; t < nt; t += 2) { \
      const bool last = (t == nt - 2); \
      const char* a1 = cA + (size_t)(t + 1) * kstep; \
      const char* a2 = last ? nA : cA + (size_t)(t + 2) * kstep; const char* b2 = last ? nB : cB + (size_t)(t + 2) * kstep; \
      const char* a3 = a2 + kstep; const char* b3 = b2 + kstep; \
      const bool wl = last ? nl : cl; const size_t h2 = wl ? hL : hS; \
      LDB(B0, 0, 0); LDB(B1, 0, 1); SCHED; LDA(At, 0, 0); STAGE2(SA_(1, 1), a1 + ch, cl); \
      WAIT_V(8); WAIT_L(0); BAR; MMA(0, 0, At, B0); MMA(0, 1, At, B1); BAR; SCHED; \
      LDA(At, 0, 1); STAGE2(SB_(0, 0), b2, wl); STAGE2(SB_(0, 1), b2 + h2, wl); STAGE2(SA_(0, 0), a2, wl); \
      WAIT_V(8); WAIT_L(0); BAR; MMA(1, 0, At, B0); MMA(1, 1, At, B1); BAR; SCHED; \
      LDB(B0, 1, 0); LDB(B1, 1, 1); SCHED; LDA(At, 1, 0); STAGE2(SA_(0, 1), a2 + h2, wl); \
      WAIT_V(8); WAIT_L(0); BAR; MMA(0, 0, At, B0); MMA(0, 1, At, B1); BAR; SCHED; \
      LDA(At, 1, 1); STAGE2(SB_(1, 0), b3, wl); STAGE2(SB_(1, 1), b3 + h2, wl); STAGE2(SA_(1, 0), a3, wl); \
      WAIT_V(8); WAIT_L(0); BAR; MMA(1, 0, At, B0); MMA(1, 1, At, B1); BAR; SCHED; \
    } \
    if (wr == 0) BAR; \
    epi(acc, pm, pn, (Q), wr, wc); \
    cA = nA; cB = nB; } while (0)
  for (;;) {
    GM_UNIT(0, GM_A(1, pm), GM_B(1, pn)); acc_zero(acc); if (wr == 1) BAR;
    GM_UNIT(1, GM_A(2, pm), GM_B(2, pn)); acc_zero(acc); if (wr == 1) BAR;
    GM_UNIT(2, GM_A(3, pm), GM_B(3, pn)); if (wr == 1) BAR;
    has_next = tile_next(ui + 1, nM, nN, npm, npn);
    GM_UNIT(3, has_next ? GM_A(0, npm) : cA, has_next ? GM_B(0, npn) : cB);
    if (!has_next) break;
    acc_zero(acc); pm = npm; pn = npn; ++ui;
    if (wr == 1) BAR;
  }
  WAIT_V(0);
  BAR;
#undef GM_UNIT
#undef GM_A
#undef GM_B
}

#define ROW_(ai, m) (128 * (ai) + 64 * wr + 16 * (m) + fr)
#define COLP_(bj) (128 * (bj) + 32 * wc + 8 * fq)
#define COLN_(bj, n) (128 * (bj) + 32 * wc + 16 * (n) + 4 * fq)
#define WLANE const int wid = __builtin_amdgcn_readfirstlane(ltid() >> 6), lane = ltid() & 63, wr = wid >> 2, wc = wid & 3, fr = lane & 15, fq = lane >> 4; (void)wid; (void)lane; (void)wr; (void)wc; (void)fr; (void)fq

DEV void phase_prep(const Params& p, char* lds) {
  const int tid = ltid(), wid = tid >> 6, lane = tid & 63;
  float* fl = (float*)lds;
  for (int job = blockIdx.x; job < 192; job += gridDim.x) {
    const int cgp = job % 24, kp = job / 24;
    __syncthreads();
    fl[tid] = p.c[(tid >> 8) * 2048 + kp * 256 + (tid & 255)];
    __syncthreads();
    f32x4 a0 = {0.f, 0.f, 0.f, 0.f}, a1 = {0.f, 0.f, 0.f, 0.f};
    const float* wp = p.w_ada + (size_t)(kp * 256 + wid) * 6144 + cgp * 256 + lane * 4;
#pragma unroll 8
    for (int it = 0; it < 32; ++it) { const f32x4 w = __builtin_nontemporal_load((const f32x4*)(wp + (size_t)it * 8 * 6144)); const int kk = it * 8 + wid; a0 += w * fl[kk]; a1 += w * fl[256 + kk]; }
    float* red = fl + 512;
    *(f32x4*)(red + (wid * 2 + 0) * 256 + lane * 4) = a0; *(f32x4*)(red + (wid * 2 + 1) * 256 + lane * 4) = a1;
    __syncthreads();
    { const int bb = tid >> 8, cc = tid & 255; float s = 0.f;
      UNR for (int w = 0; w < 8; ++w) s += red[(w * 2 + bb) * 256 + cc];
      ((float*)(p.ws + OFF_MODP))[(size_t)(kp * 2 + bb) * 6144 + cgp * 256 + cc] = s; }
  }
  constexpr int T_MAIN = 144 * 32, T_G = 64 * 32, T_PA = 32 * 16, T_PM = 32 * 16, T_OUT = 32 * 32;
  constexpr int T_ALL = T_MAIN + T_G + T_PA + T_PM + T_OUT;
  for (int jg = blockIdx.x; jg < T_ALL / 4; jg += gridDim.x) {
    const float* src; int ld, K, nt_, kt_, scol; u16* dst; int j = jg * 4;
    if (j < T_MAIN) { nt_ = j / 32; kt_ = j % 32; src = p.w_in; ld = INC; K = 2048; dst = (u16*)(p.ws + OFF_WMAIN);
      const int cp = nt_ * 64; scol = cp < 3072 ? cp : (cp < 6144 ? cp + 1024 : (cp < 7168 ? cp - 3072 : cp)); }
    else if ((j -= T_MAIN) < T_G) { nt_ = j / 32; kt_ = j % 32; src = p.w_in; ld = INC; K = 2048; dst = (u16*)(p.ws + OFF_WG); scol = 9224 + nt_ * 64; }
    else if ((j -= T_G) < T_PA) { nt_ = j / 16; kt_ = j % 16; src = p.w_pa; ld = 2048; K = 1024; dst = (u16*)(p.ws + OFF_WPA); scol = nt_ * 64; }
    else if ((j -= T_PA) < T_PM) { nt_ = j / 16; kt_ = j % 16; src = p.w_pm; ld = 2048; K = 1024; dst = (u16*)(p.ws + OFF_WPM); scol = nt_ * 64; }
    else { j -= T_PM; nt_ = j / 32; kt_ = j % 32; src = p.w_out; ld = 2048; K = 2048; dst = (u16*)(p.ws + OFF_WOUT); scol = nt_ * 64; }
    __syncthreads();
    { const int r = tid >> 4, c4 = (tid & 15) * 4;
      const float* g = src + (size_t)(kt_ * 64 + r) * ld + scol + c4;
      f32x4 v[8];
      UNR for (int q = 0; q < 8; ++q) v[q] = __builtin_nontemporal_load((const f32x4*)(g + (size_t)q * 32 * ld));
      UNR for (int q = 0; q < 8; ++q) { float* t = fl + (q >> 1) * 4160 + ((q & 1) * 32 + r) * 65 + c4; t[0] = v[q][0]; t[1] = v[q][1]; t[2] = v[q][2]; t[3] = v[q][3]; } }
    __syncthreads();
    { const int nrow = tid >> 3, k8 = tid & 7; const int ncol = (nrow & 32) + perm32(nrow & 31);
      UNR for (int t = 0; t < 4; ++t) {
        float v[8]; UNR for (int jj = 0; jj < 8; ++jj) v[jj] = fl[t * 4160 + (k8 * 8 + jj) * 65 + ncol];
        u32x4 w; w.x = pk_bf16(v[0], v[1]); w.y = pk_bf16(v[2], v[3]); w.z = pk_bf16(v[4], v[5]); w.w = pk_bf16(v[6], v[7]);
        *(u32x4*)(dst + (size_t)(nt_ * 64 + nrow) * K + (kt_ + t) * 64 + k8 * 8) = w; } }
  }
}

DEV void phase_h(const Params& p, char* lds) {
  const int tid = ltid(), wid = tid >> 6, lane = tid & 63;
  float* gsc = (float*)lds; float* sh = gsc + 2048; float* wif = sh + 2048;
  const float* modp = (const float*)(p.ws + OFF_MODP);
  u16* H = (u16*)(p.ws + OFF_H); float* IFG = (float*)(p.ws + OFF_IFG);
  for (int rb = blockIdx.x; rb < NTOK / 64; rb += gridDim.x) {
    const int b = (rb * 64) / SEQ;
    __syncthreads();
    for (int i = tid; i < 2048; i += NTHR) { float s0 = p.b_ada[i], s1 = p.b_ada[2048 + i];
      UNR for (int kp = 0; kp < 8; ++kp) { s0 += modp[(size_t)(kp * 2 + b) * 6144 + i]; s1 += modp[(size_t)(kp * 2 + b) * 6144 + 2048 + i]; }
      gsc[i] = p.norm_gain[i] * (1.0f + s1); sh[i] = s0; }
    if ((rb & 127) == 0) for (int i = tid; i < 2048; i += NTHR) { float s2 = p.b_ada[4096 + i];
      UNR for (int kp = 0; kp < 8; ++kp) s2 += modp[(size_t)(kp * 2 + b) * 6144 + 4096 + i];
      ((float*)(p.ws + OFF_MOD))[b * 6144 + 4096 + i] = s2; }
    for (int i = tid; i < 4096; i += NTHR) { const int k = i >> 1, hf = i & 1; const f32x4 wv4 = *(const f32x4*)(p.w_in + (size_t)k * INC + 9216 + hf * 4);
      UNR for (int e = 0; e < 4; ++e) wif[(hf * 4 + e) * 2048 + k] = wv4[e]; }
    __syncthreads();
    const float* xr0 = p.x + (size_t)(rb * 64 + wid * 8) * DM + lane * 4;
    f32x4 xn[8];
    UNR for (int i = 0; i < 8; ++i) xn[i] = __builtin_nontemporal_load((const f32x4*)(xr0 + 256 * i));
#pragma unroll 1
    for (int rr = 0; rr < 8; ++rr) {
      const int row = rb * 64 + wid * 8 + rr;
      f32x4 xv[8]; float ss = 0.f;
      UNR for (int i = 0; i < 8; ++i) { xv[i] = xn[i]; ss += xv[i][0] * xv[i][0] + xv[i][1] * xv[i][1] + xv[i][2] * xv[i][2] + xv[i][3] * xv[i][3]; }
      if (rr < 7) { UNR for (int i = 0; i < 8; ++i) xn[i] = __builtin_nontemporal_load((const f32x4*)(xr0 + (size_t)(rr + 1) * DM + 256 * i)); }
      ss = wave_sum(ss);
      const float rstd = rsqrtf(ss * (1.0f / 2048.0f) + 1e-6f);
      float a[8]; UNR for (int j = 0; j < 8; ++j) a[j] = 0.f;
      UNR for (int i = 0; i < 8; ++i) { const int c0 = lane * 4 + 256 * i;
        const f32x4 gv = *(const f32x4*)(gsc + c0), sv = *(const f32x4*)(sh + c0);
        const f32x4 hv = xv[i] * rstd * gv + sv;
        UNR for (int j = 0; j < 8; ++j) { const f32x4 wj = *(const f32x4*)(wif + j * 2048 + c0); a[j] += hv[0] * wj[0] + hv[1] * wj[1] + hv[2] * wj[2] + hv[3] * wj[3]; }
        u32x2 w; w.x = pk_bf16(hv[0], hv[1]); w.y = pk_bf16(hv[2], hv[3]);
        *(u32x2*)(H + (size_t)row * DM + c0) = w;
        asm volatile("" ::: "memory"); }
      UNR for (int j = 0; j < 8; ++j) a[j] = wave_sum(a[j]);
      if (lane < 8) { float v = a[0]; for (int j = 1; j < 8; ++j) v = (lane == j) ? a[j] : v; IFG[(size_t)row * 8 + lane] = v + p.b_gate_if[lane]; }
    }
  }
}

DEV void phase_gemm_main(const Params& p, char* lds) {
  const u16* H = (const u16*)(p.ws + OFF_H); const u16* W = (const u16*)(p.ws + OFF_WMAIN); char* ws = p.ws;
  gemm_stream(H, DM, W, DM, DM, 64, 36, (lchar*)lds, [=](const f32x4 (&acc)[2][2][4][2], int pm, int pn, int wr, int wc, int fr, int fq) {
    const int cb = pn * 256, buf = cb / 3072, cc = cb % 3072;
    u16* O = (u16*)(ws + (buf == 0 ? OFF_P1 : (buf == 1 ? OFF_P2 : OFF_P3)));
    UNR for (int ai = 0; ai < 2; ++ai) UNR for (int m = 0; m < 4; ++m) { u16* rp = O + (size_t)(pm * 256 + ROW_(ai, m)) * 3072 + cc;
      UNR for (int bj = 0; bj < 2; ++bj) { const f32x4 v0 = acc[ai][bj][m][0], v1 = acc[ai][bj][m][1]; u32x4 w;
        w.x = pk_bf16(v0[0], v0[1]); w.y = pk_bf16(v0[2], v0[3]); w.z = pk_bf16(v1[0], v1[1]); w.w = pk_bf16(v1[2], v1[3]);
        *(u32x4*)(rp + COLP_(bj)) = w; } }
  });
}

template <int OFF> DEV u32x2 tr_read(unsigned addr) { u32x2 r; asm volatile("ds_read_b64_tr_b16 %0, %1 offset:%2" : "=&v"(r) : "v"(addr), "i"(OFF) : "memory"); return r; }
#define TR2(c) v0[c] = tr_read<(c) * 32>(vb); v1[c] = tr_read<1088 + (c) * 32>(vb);
constexpr int ABUF = 69632, AVOFF = 34816;
DEV void attn_chunk(const Params& p, char* lds_, int ci) {
  lchar* lds = (lchar*)lds_;
  const int tid = ltid(), wid = __builtin_amdgcn_readfirstlane(tid >> 6), lane = tid & 63, fr = lane & 15, g = lane >> 4;
  const int pat = ci >> 8, rem = ci & 255;
  const int d = pat == 0 ? 1 : (pat == 1 ? 4 : 16), cps = 16 / d;
  const int cpos = rem % cps, stream = rem / cps, r = stream % d, bh = stream / d, b = bh >> 3, h = bh & 7;
  const int n0 = cpos * 4;
  const u16* P1 = (const u16*)(p.ws + OFF_P1) + (size_t)b * SEQ * 3072 + h * 128;
  const int lrow = tid >> 4, lch = tid & 15;
  u32x4 kreg[4], vreg[4];
  __syncthreads();
  const int qi = 16 * wid + fr;
  bf16x8 qn[4];
  { u32x4 kr2[4], vr2[4];
    if (n0 > 0) {
      UNR for (int ps = 0; ps < 4; ++ps) { const int tk = ((n0 - 1) * 128 + lrow + 32 * ps) * d + r; const u16* s = P1 + (size_t)tk * 3072 + lch * 8; kreg[ps] = *(const u32x4*)(s + 1024); vreg[ps] = *(const u32x4*)(s + 2048); }
    } else {
      UNR for (int ps = 0; ps < 4; ++ps) { kreg[ps] = (u32x4){0u, 0u, 0u, 0u}; vreg[ps] = (u32x4){0u, 0u, 0u, 0u}; }
    }
    UNR for (int ps = 0; ps < 4; ++ps) { const int tk = (n0 * 128 + lrow + 32 * ps) * d + r; const u16* s = P1 + (size_t)tk * 3072 + lch * 8; kr2[ps] = *(const u32x4*)(s + 1024); vr2[ps] = *(const u32x4*)(s + 2048); }
    { const u16* qp = P1 + (size_t)((n0 * 128 + qi) * d + r) * 3072 + 8 * g;
      UNR for (int s = 0; s < 4; ++s) qn[s] = *(const bf16x8*)(qp + 32 * s); }
    UNR for (int ps = 0; ps < 4; ++ps) { *(LAS u32x4*)(lds + (lrow + 32 * ps) * 272 + lch * 16) = kreg[ps]; *(LAS u32x4*)(lds + AVOFF + (lrow + 32 * ps) * 272 + lch * 16) = vreg[ps]; }
    UNR for (int ps = 0; ps < 4; ++ps) { *(LAS u32x4*)(lds + ABUF + (lrow + 32 * ps) * 272 + lch * 16) = kr2[ps]; *(LAS u32x4*)(lds + ABUF + AVOFF + (lrow + 32 * ps) * 272 + lch * 16) = vr2[ps]; } }
  __syncthreads();
  const float c1 = 0.08838834764831845f * 1.4426950408889634f, c2 = exp2f(-(float)(h + 1)) * (float)d * 1.4426950408889634f;
#pragma unroll 1
  for (int i = 0; i < 4; ++i) {
    const int nq = n0 + i;
    lchar* prevB = lds + (i & 1) * ABUF; lchar* curB = lds + ((i + 1) & 1) * ABUF;
    const int tq = (nq * 128 + qi) * d + r;
    bf16x8 qf[4];
    UNR for (int s = 0; s < 4; ++s) qf[s] = qn[s];
    if (i < 3) {
      UNR for (int ps = 0; ps < 4; ++ps) { const int tk = ((nq + 1) * 128 + lrow + 32 * ps) * d + r; const u16* s = P1 + (size_t)tk * 3072 + lch * 8; kreg[ps] = *(const u32x4*)(s + 1024); vreg[ps] = *(const u32x4*)(s + 2048); }
      const u16* qp = P1 + (size_t)(((nq + 1) * 128 + qi) * d + r) * 3072 + 8 * g;
      UNR for (int s = 0; s < 4; ++s) qn[s] = *(const bf16x8*)(qp + 32 * s);
    }
    const int u = wid >> 1;
    int gofs[5];
#pragma unroll
    for (int kq = 0; kq < 5; ++kq) { const int ks = u + kq; gofs[kq] = (((ks < 4) ? (i & 1) : ((i + 1) & 1)) * ABUF) + (ks & 3) * 8704; }
    f32x4 sc[5][2];
    { const int koff = (8 * (fr >> 2) + (fr & 3)) * 272 + 16 * g;
      bf16x8 kfa[8], kfb[8];
#pragma unroll
      for (int q = 0; q < 8; ++q) kfa[q] = *(const LAS bf16x8*)(lds + gofs[0] + koff + (q >> 2) * 1088 + 64 * (q & 3));
#pragma unroll
      for (int kq = 0; kq < 5; ++kq) {
        if (kq < 4) {
#pragma unroll
          for (int q = 0; q < 8; ++q) { const bf16x8 v = *(const LAS bf16x8*)(lds + gofs[kq + 1] + koff + (q >> 2) * 1088 + 64 * (q & 3)); if (kq & 1) kfa[q] = v; else kfb[q] = v; }
        }
        SCHED;
#pragma unroll
        for (int t = 0; t < 2; ++t) {
          f32x4 a = {0.f, 0.f, 0.f, 0.f};
#pragma unroll
          for (int s = 0; s < 4; ++s) a = __builtin_amdgcn_mfma_f32_16x16x32_bf16((kq & 1) ? kfb[t * 4 + s] : kfa[t * 4 + s], qf[s], a, 0, 0, 0);
          sc[kq][t] = a;
        }
        SCHED;
      } }
    const int dbl = 16 * (wid & 1) + fr - 8 * g + 128;
    const float b0 = -c2 * (float)dbl;
    float mx = -INFINITY;
#pragma unroll
    for (int kq = 0; kq < 5; ++kq) {
      const bool gval = (nq > 0) || (u + kq >= 4);
#pragma unroll
      for (int t = 0; t < 2; ++t) {
#pragma unroll
        for (int j = 0; j < 4; ++j) {
          const int kk = 32 * kq + 4 * t + j;
          float s = __builtin_fmaf(sc[kq][t][j], c1, __builtin_fmaf(c2, (float)kk, b0));
          bool valid = gval;
          if (kq == 0) valid = valid && (dbl - kk <= 128);
          if (kq == 4) valid = valid && (dbl - kk >= 0);
          s = valid ? s : -INFINITY;
          sc[kq][t][j] = s; mx = fmaxf(mx, s);
        } } }
    mx = fmaxf(mx, __shfl_xor(mx, 16)); mx = fmaxf(mx, __shfl_xor(mx, 32));
    float sum = 0.f;
#pragma unroll
    for (int kq = 0; kq < 5; ++kq) {
#pragma unroll
      for (int t = 0; t < 2; ++t) {
#pragma unroll
        for (int j = 0; j < 4; ++j) { const float e = __builtin_amdgcn_exp2f(sc[kq][t][j] - mx); sc[kq][t][j] = e; sum += e; } } }
    sum += __shfl_xor(sum, 16); sum += __shfl_xor(sum, 32);
    const float inv = __builtin_amdgcn_rcpf(sum);
    f32x4 oc[8];
#pragma unroll
    for (int c = 0; c < 8; ++c) oc[c] = (f32x4){0.f, 0.f, 0.f, 0.f};
    const unsigned vlane = (unsigned)(size_t)lds + AVOFF + (8 * g + (fr >> 2)) * 272 + 8 * (fr & 3);
    u32x2 va0[8], va1[8], vb0[8], vb1[8];
#define TRA(c) va0[c] = tr_read<(c) * 32>(vb); va1[c] = tr_read<1088 + (c) * 32>(vb);
#define TRB(c) vb0[c] = tr_read<(c) * 32>(vb); vb1[c] = tr_read<1088 + (c) * 32>(vb);
    { const unsigned vb = vlane + gofs[0]; TRA(0) TRA(1) TRA(2) TRA(3) TRA(4) TRA(5) TRA(6) TRA(7) }
#pragma unroll
    for (int kq = 0; kq < 5; ++kq) {
      union { bf16x8 v; unsigned u[4]; } pf;
      pf.u[0] = pk_bf16(sc[kq][0][0], sc[kq][0][1]); pf.u[1] = pk_bf16(sc[kq][0][2], sc[kq][0][3]);
      pf.u[2] = pk_bf16(sc[kq][1][0], sc[kq][1][1]); pf.u[3] = pk_bf16(sc[kq][1][2], sc[kq][1][3]);
      asm volatile("s_waitcnt lgkmcnt(0)" ::: "memory"); SCHED;
      if (kq < 4) { const unsigned vb = vlane + gofs[kq + 1];
        if (kq & 1) { TRA(0) TRA(1) TRA(2) TRA(3) TRA(4) TRA(5) TRA(6) TRA(7) } else { TRB(0) TRB(1) TRB(2) TRB(3) TRB(4) TRB(5) TRB(6) TRB(7) } }
#pragma unroll
      for (int c = 0; c < 8; ++c) {
        union { bf16x8 v; unsigned u[4]; } vf;
        if (kq & 1) { vf.u[0] = vb0[c].x; vf.u[1] = vb0[c].y; vf.u[2] = vb1[c].x; vf.u[3] = vb1[c].y; }
        else { vf.u[0] = va0[c].x; vf.u[1] = va0[c].y; vf.u[2] = va1[c].x; vf.u[3] = va1[c].y; }
        oc[c] = __builtin_amdgcn_mfma_f32_16x16x32_bf16(vf.v, pf.v, oc[c], 0, 0, 0);
      }
    }
    { u16* O = (u16*)((char*)p.out + DO_OATT) + ((size_t)pat * NTOK + (size_t)(b * SEQ + tq)) * 1024 + h * 128 + 4 * g;
#pragma unroll
      for (int c = 0; c < 8; ++c) { u32x2 w; w.x = pk_bf16(oc[c][0] * inv, oc[c][1] * inv); w.y = pk_bf16(oc[c][2] * inv, oc[c][3] * inv); *(u32x2*)(O + 16 * c) = w; }
      if (g == 0) ((float*)(p.ws + OFF_LSE))[((size_t)pat * NTOK + (size_t)(b * SEQ + tq)) * 8 + h] = (mx + __builtin_amdgcn_logf(sum)) * 0.6931471805599453f; }
    __syncthreads();
    if (i < 3) {
      UNR for (int ps = 0; ps < 4; ++ps) { *(LAS u32x4*)(prevB + (lrow + 32 * ps) * 272 + lch * 16) = kreg[ps]; *(LAS u32x4*)(prevB + AVOFF + (lrow + 32 * ps) * 272 + lch * 16) = vreg[ps]; }
    }
    __syncthreads();
  }
}

DEV void mprep_item(const Params& p, char* lds, int item) {
  const int tid = ltid();
  const int k = item & 31, h = (item >> 5) & 3, b = item >> 7;
  const int tok0 = b * SEQ + k * 256;
  char* Ts = lds;
  float* sa = (float*)(lds + 135168); float* sb = sa + 256; float* sw = sb + 256; float* red = sw + 256;
  const float* IFG = (const float*)(p.ws + OFF_IFG);
  const u16* P2 = (const u16*)(p.ws + OFF_P2);
  __syncthreads();
  float iv = 0.f, av = 0.f, cv = 0.f;
  if (tid < 256) { const float f = IFG[(size_t)(tok0 + tid) * 8 + 4 + h]; iv = IFG[(size_t)(tok0 + tid) * 8 + h];
    av = fminf(f, 0.f) - log1pf(__expf(-fabsf(f))); sa[tid] = av; }
  __syncthreads();
  for (int off = 1; off < 256; off <<= 1) { float t = 0.f; if (tid < 256 && tid >= off) t = sa[tid - off]; __syncthreads(); if (tid < 256) { av += t; sa[tid] = av; } __syncthreads(); }
  if (tid < 256) { cv = iv - av; sb[tid] = cv; }
  float cm = cv;
  __syncthreads();
  for (int off = 1; off < 256; off <<= 1) { float t = -INFINITY; if (tid < 256 && tid >= off) t = sb[tid - off]; __syncthreads(); if (tid < 256) { cm = fmaxf(cm, t); sb[tid] = cm; } __syncthreads(); }
  const float cmall = sb[255], Aall = sa[255];
  if (tid < 256) { const size_t ix = (size_t)(tok0 + tid) * 4 + h;
    ((float*)(p.ws + OFF_SA))[ix] = av; ((float*)(p.ws + OFF_SC))[ix] = cv; ((float*)(p.ws + OFF_SCM))[ix] = cm;
    sw[tid] = __expf(cv - cmall); }
  if (tid == 0) { ((float*)(p.ws + OFF_IA))[item] = Aall; ((float*)(p.ws + OFF_IG))[item] = Aall + cmall; }
  __syncthreads();
  u16* QC = (u16*)(p.ws + OFF_QC); u16* KC = (u16*)(p.ws + OFF_KC);
  float* nup = red;
  { const int cgp = tid & 31, rg = tid >> 5, e0 = cgp * 8, ch = h * 256 + e0, t0 = rg * 16;
#pragma unroll 1
    for (int pass = 0; pass < 2; ++pass) {
      const int wofs = pass * 1024 + ch;
      float wv[4][8], bv[8];
      UNR for (int e = 0; e < 8; ++e) bv[e] = p.conv_b[wofs + e];
      UNR for (int j = 0; j < 4; ++j) { UNR for (int e = 0; e < 8; ++e) wv[j][e] = p.conv_w[(size_t)j * 2048 + wofs + e]; }
      float ns[8]; UNR for (int e = 0; e < 8; ++e) ns[e] = 0.f;
#pragma unroll 1
      for (int half = 0; half < 2; ++half) {
      u32x4 rows[11];
      UNR for (int i = 0; i < 11; ++i) { const int pos = k * 256 + t0 + half * 8 + i - 3;
        rows[i] = (pos >= 0) ? __builtin_nontemporal_load((const u32x4*)(P2 + (size_t)(tok0 + t0 + half * 8 + i - 3) * 3072 + pass * 1024 + ch)) : (u32x4){0u, 0u, 0u, 0u}; }
      UNR for (int i = 0; i < 8; ++i) {
        float acc8[8]; UNR for (int e = 0; e < 8; ++e) acc8[e] = bv[e];
        UNR for (int j = 0; j < 4; ++j) { const u32x4 rv = rows[i + j]; const unsigned ru[4] = {rv.x, rv.y, rv.z, rv.w};
          UNR for (int e = 0; e < 4; ++e) { acc8[2 * e] += wv[j][2 * e] * bflo(ru[e]); acc8[2 * e + 1] += wv[j][2 * e + 1] * bfhi(ru[e]); } }
        const int t = t0 + half * 8 + i;
        if (pass == 0) {
          UNR for (int e = 0; e < 8; ++e) acc8[e] = siluf_(acc8[e]);
          u32x4 o; o.x = pk_bf16(acc8[0], acc8[1]); o.y = pk_bf16(acc8[2], acc8[3]); o.z = pk_bf16(acc8[4], acc8[5]); o.w = pk_bf16(acc8[6], acc8[7]);
          *(u32x4*)(QC + (size_t)(tok0 + t) * 1024 + ch) = o;
        } else {
          const float w = sw[t]; float kw[8];
          UNR for (int e = 0; e < 8; ++e) { acc8[e] = siluf_(acc8[e]) * 0.0625f; kw[e] = acc8[e] * w; }
          u32x4 o; o.x = pk_bf16(acc8[0], acc8[1]); o.y = pk_bf16(acc8[2], acc8[3]); o.z = pk_bf16(acc8[4], acc8[5]); o.w = pk_bf16(acc8[6], acc8[7]);
          *(u32x4*)(KC + (size_t)(tok0 + t) * 1024 + ch) = o;
          o.x = pk_bf16(kw[0], kw[1]); o.y = pk_bf16(kw[2], kw[3]); o.z = pk_bf16(kw[4], kw[5]); o.w = pk_bf16(kw[6], kw[7]);
          *(u32x4*)(Ts + t * 528 + e0 * 2) = o;
          const unsigned ou[4] = {o.x, o.y, o.z, o.w};
          UNR for (int e = 0; e < 4; ++e) { ns[2 * e] += bflo(ou[e]); ns[2 * e + 1] += bfhi(ou[e]); }
        }
        asm volatile("" ::: "memory");
      }
      }
      if (pass == 1) { *(f32x4*)(nup + rg * 256 + e0) = (f32x4){ns[0], ns[1], ns[2], ns[3]}; *(f32x4*)(nup + rg * 256 + e0 + 4) = (f32x4){ns[4], ns[5], ns[6], ns[7]}; }
    } }
  __syncthreads();
  const int wid = __builtin_amdgcn_readfirstlane(tid >> 6), lane = tid & 63, li = lane & 15, lg = lane >> 4;
  const unsigned trl = (unsigned)(size_t)(lchar*)lds + (8 * lg + (li >> 2)) * 528 + 8 * (li & 3);
  { u16* KWT = (u16*)(p.ws + OFF_KWT) + (size_t)item * 65536;
#pragma unroll 1
    for (int j4 = 0; j4 < 4; ++j4) { u32x2 ra[4], rb[4];
      UNR for (int q = 0; q < 4; ++q) { const int uq = wid * 16 + j4 * 4 + q, eb = (uq & 15) * 16, sb2 = (uq >> 4) * 32; const unsigned ad = trl + sb2 * 528 + eb * 2;
        ra[q] = tr_read<0>(ad); rb[q] = tr_read<4 * 528>(ad); }
      asm volatile("s_waitcnt lgkmcnt(0)" ::: "memory"); SCHED;
      UNR for (int q = 0; q < 4; ++q) { const int uq = wid * 16 + j4 * 4 + q, eb = (uq & 15) * 16, sb2 = (uq >> 4) * 32;
        u32x4 o; o.x = ra[q].x; o.y = ra[q].y; o.z = rb[q].x; o.w = rb[q].y; *(u32x4*)(KWT + (size_t)(eb + li) * 256 + sb2 + 8 * lg) = o; } }
    if (tid < 256) { float s = 0.f; UNR for (int q = 0; q < 16; ++q) s += nup[q * 256 + tid]; ((float*)(p.ws + OFF_NU))[(size_t)item * 256 + tid] = s; } }
  __syncthreads();
  { u32x4 vr[16];
    UNR for (int itr = 0; itr < 16; ++itr) { const int u = tid + NTHR * itr, t = u >> 5, e0 = (u & 31) * 8; vr[itr] = __builtin_nontemporal_load((const u32x4*)(P2 + (size_t)(tok0 + t) * 3072 + 2048 + h * 256 + e0)); }
    UNR for (int itr = 0; itr < 16; ++itr) { const int u = tid + NTHR * itr, t = u >> 5, e0 = (u & 31) * 8; *(u32x4*)(Ts + t * 528 + e0 * 2) = vr[itr]; } }
  __syncthreads();
  { u16* VT = (u16*)((char*)p.out + DO_VT) + (size_t)item * 65536;
#pragma unroll 1
    for (int j4 = 0; j4 < 4; ++j4) { u32x2 ra[4], rb[4];
      UNR for (int q = 0; q < 4; ++q) { const int uq = wid * 16 + j4 * 4 + q, eb = (uq & 15) * 16, sb2 = (uq >> 4) * 32; const unsigned ad = trl + sb2 * 528 + eb * 2;
        ra[q] = tr_read<0>(ad); rb[q] = tr_read<4 * 528>(ad); }
      asm volatile("s_waitcnt lgkmcnt(0)" ::: "memory"); SCHED;
      UNR for (int q = 0; q < 4; ++q) { const int uq = wid * 16 + j4 * 4 + q, eb = (uq & 15) * 16, sb2 = (uq >> 4) * 32;
        u32x4 o; o.x = ra[q].x; o.y = ra[q].y; o.z = rb[q].x; o.w = rb[q].y; *(u32x4*)(VT + (size_t)(eb + li) * 256 + sb2 + 8 * lg) = o; } } }
}


DEV void u_item(const Params& p, char* lds, int item) {
  WLANE; lchar* shm = (lchar*)lds;
  f32x4 acc[2][2][4][2]; acc_zero(acc);
  gemm_kloop(acc, (const u16*)((char*)p.out + DO_VT) + (size_t)item * 65536, 256, (const u16*)(p.ws + OFF_KWT) + (size_t)item * 65536, 256, 256, shm);
  { RELANE; u16* rp = (u16*)(p.ws + OFF_KWT) + (size_t)item * 65536 + (size_t)ROW_(0, 0) * 256 + COLP_(0);
    UNR for (int ai = 0; ai < 2; ++ai) UNR for (int m = 0; m < 4; ++m) { u16* q = rp + (ai * 128 + m * 16) * 256; asm volatile("" : "+v"(q) :: "memory");
      UNR for (int bj = 0; bj < 2; ++bj) { const f32x4 v0 = acc[ai][bj][m][0], v1 = acc[ai][bj][m][1]; u32x4 w;
        w.x = pk_bf16(v0[0], v0[1]); w.y = pk_bf16(v0[2], v0[3]); w.z = pk_bf16(v1[0], v1[1]); w.w = pk_bf16(v1[2], v1[3]); *(u32x4*)(q + bj * 128) = w; } } }
}

DEV void phase_d1(const Params& p, char* lds) {
  const bool attn_first = (blockIdx.x >> 3) & 1;
  if (attn_first) for (int ci = blockIdx.x; ci < 768; ci += gridDim.x) attn_chunk(p, lds, ci);
  for (int item = blockIdx.x; item < 256; item += gridDim.x) { mprep_item(p, lds, item);
    asm volatile("s_waitcnt vmcnt(0)" ::: "memory"); __syncthreads();
    u_item(p, lds, item); }
#if PROBE_DUP == 20
  for (int item = blockIdx.x; item < 256; item += gridDim.x) mprep_item(p, lds, item);
#endif
#if PROBE_DUP == 21
  for (int ci = blockIdx.x; ci < 768; ci += gridDim.x) attn_chunk(p, lds, ci);
#endif
  if (!attn_first) for (int ci = blockIdx.x; ci < 768; ci += gridDim.x) attn_chunk(p, lds, ci);
}

DEV void phase_scan(const Params& p, char* lds) {
  const float* IA = (const float*)(p.ws + OFF_IA); const float* IG = (const float*)(p.ws + OFF_IG);
  const int nthreads = gridDim.x * NTHR;
  for (int gid = blockIdx.x * NTHR + ltid(); gid < 8 * 16384; gid += nthreads) {
    const int bh = gid >> 14, idx = (gid & 16383) * 4;
    f32x4 C = {0.f, 0.f, 0.f, 0.f}; float m = 0.f;
    const u16* Ub = (const u16*)(p.ws + OFF_KWT) + (size_t)(bh * 32) * 65536 + idx;
    u32x2 ua[8], ub[8];
    UNR for (int j = 0; j < 8; ++j) ua[j] = __builtin_nontemporal_load((const u32x2*)(Ub + (size_t)j * 65536));
#pragma unroll
    for (int kb = 0; kb < 4; ++kb) {
      if (kb < 3) { UNR for (int j = 0; j < 8; ++j) { const u32x2 v = __builtin_nontemporal_load((const u32x2*)(Ub + (size_t)((kb + 1) * 8 + j) * 65536)); if (kb & 1) ua[j] = v; else ub[j] = v; } }
      UNR for (int j = 0; j < 8; ++j) { const int item = bh * 32 + kb * 8 + j;
        u32x2 w; w.x = pk_bf16(C[0], C[1]); w.y = pk_bf16(C[2], C[3]);
        *(u32x2*)((u16*)(p.ws + OFF_CT) + (size_t)item * 65536 + idx) = w;
        if (idx == 0) ((float*)(p.ws + OFF_MK))[item] = m;
        const float A = IA[item], G = IG[item], mn = fmaxf(A + m, G), al = __expf(A + m - mn), be = __expf(G - mn);
        const u32x2 uv = (kb & 1) ? ub[j] : ua[j];
        const f32x4 u = {bflo(uv.x), bfhi(uv.x), bflo(uv.y), bfhi(uv.y)};
        C = C * al + u * be; m = mn; } }
  }
  for (int gid = blockIdx.x * NTHR + ltid(); gid < 2048; gid += nthreads) {
    const int bh = gid >> 8, e = gid & 255; float n = 0.f, m = 0.f;
    for (int k = 0; k < 32; ++k) { const int item = bh * 32 + k;
      ((float*)(p.ws + OFF_NK))[(size_t)item * 256 + e] = n;
      const float A = IA[item], G = IG[item], mn = fmaxf(A + m, G), al = __expf(A + m - mn), be = __expf(G - mn);
      n = n * al + ((const float*)(p.ws + OFF_NU))[(size_t)item * 256 + e] * be; m = mn; }
  }
}

DEV void mout_item(const Params& p, char* lds, int item) {
  WLANE; const int tid = ltid(); lchar* shm = (lchar*)lds;
  const int k = item & 31, h = (item >> 5) & 3, b = item >> 7; (void)k;
  const int tok0 = b * SEQ + (item & 31) * 256;
  float* sMt = (float*)(lds + 131072); float* sWin = sMt + 256; float* sCs = sWin + 256; float* sEm = sCs + 256; float* sQn = sEm + 256;
  float* sRow = sQn + 256;
  float* sR1 = (float*)lds; float* sR2 = sR1 + 1024;
  const u16* QC = (const u16*)(p.ws + OFF_QC) + (size_t)tok0 * 1024 + h * 256;
  const u16* KC = (const u16*)(p.ws + OFF_KC) + (size_t)tok0 * 1024 + h * 256;
  const float mk = ((const float*)(p.ws + OFF_MK))[item];
  __syncthreads();
  if (tid < 256) { const size_t ix = (size_t)(tok0 + tid) * 4 + h;
    const float a = ((const float*)(p.ws + OFF_SA))[ix], c = ((const float*)(p.ws + OFF_SC))[ix], cm = ((const float*)(p.ws + OFF_SCM))[ix];
    const float Mt = fmaxf(mk, cm); sMt[tid] = Mt; sWin[tid] = __expf(mk - Mt); sCs[tid] = c; sEm[tid] = __expf(-(a + Mt)); }
  { const float* NK = (const float*)(p.ws + OFF_NK) + (size_t)item * 256;
    const f32x4 nv = *(const f32x4*)(NK + lane * 4);
#pragma unroll 1
    for (int r8 = 0; r8 < 4; ++r8) { u32x2 qv[8];
      UNR for (int j = 0; j < 8; ++j) qv[j] = *(const u32x2*)(QC + (size_t)(wid * 32 + r8 * 8 + j) * 1024 + lane * 4);
      UNR for (int j = 0; j < 8; ++j) { float s = bflo(qv[j].x) * nv[0] + bfhi(qv[j].x) * nv[1] + bflo(qv[j].y) * nv[2] + bfhi(qv[j].y) * nv[3];
        s = wave_sum(s); if (lane == 0) sQn[wid * 32 + r8 * 8 + j] = s; } } }
  __syncthreads();
  f32x4 acc[2][2][4][2]; acc_zero(acc);
  gemm_kloop(acc, launder(QC), 1024, launder(KC), 1024, 256, shm);
  { RELANE; u16* PB = launder((u16*)(p.ws + OFF_PB) + (size_t)item * 65536);
    UNR for (int ai = 0; ai < 2; ++ai) UNR for (int m = 0; m < 4; ++m) { const int t = ROW_(ai, m); const float Mt = sMt[t]; float rs = 0.f;
      UNR for (int bj = 0; bj < 2; ++bj) { const int s0 = COLP_(bj); float pv[8];
        const f32x4 c0 = *(const f32x4*)(sCs + s0), c1 = *(const f32x4*)(sCs + s0 + 4);
        UNR for (int j = 0; j < 4; ++j) { const float m0 = (s0 + j <= t) ? 1.0f : 0.0f, m1 = (s0 + 4 + j <= t) ? 1.0f : 0.0f;
          pv[j] = m0 * acc[ai][bj][m][0][j] * __expf(fminf(c0[j] - Mt, 0.f)); pv[4 + j] = m1 * acc[ai][bj][m][1][j] * __expf(fminf(c1[j] - Mt, 0.f)); rs += pv[j] + pv[4 + j]; }
        u32x4 w; w.x = pk_bf16(pv[0], pv[1]); w.y = pk_bf16(pv[2], pv[3]); w.z = pk_bf16(pv[4], pv[5]); w.w = pk_bf16(pv[6], pv[7]); *(u32x4*)(PB + (size_t)t * 256 + s0) = w; }
      rs += __shfl_xor(rs, 16); rs += __shfl_xor(rs, 32);
      if (fq == 0) sRow[wc * 256 + t] = rs;
      asm volatile("" ::: "memory"); } }
  asm volatile("s_waitcnt vmcnt(0)" ::: "memory"); __syncthreads();
  acc_zero(acc);
  gemm_kloop(acc, launder(QC), 1024, launder((const u16*)(p.ws + OFF_CT) + (size_t)item * 65536), 256, 256, shm);
  { RELANE;
    UNR for (int ai = 0; ai < 2; ++ai) UNR for (int m = 0; m < 4; ++m) { const float w = sWin[ROW_(ai, m)];
      UNR for (int bj = 0; bj < 2; ++bj) UNR for (int n = 0; n < 2; ++n) acc[ai][bj][m][n] = acc[ai][bj][m][n] * w; } }
  gemm_kloop(acc, launder((const u16*)(p.ws + OFF_PB) + (size_t)item * 65536), 256, launder((const u16*)((char*)p.out + DO_VT) + (size_t)item * 65536), 256, 256, shm);
  { RELANE; const u16* P3 = launder((const u16*)(p.ws + OFF_P3) + (size_t)tok0 * 3072 + 1024 + h * 256);
    UNR for (int ai = 0; ai < 2; ++ai) { u32x4 ov[4][2];
      UNR for (int m = 0; m < 4; ++m) UNR for (int bj = 0; bj < 2; ++bj) ov[m][bj] = __builtin_nontemporal_load((const u32x4*)(P3 + (size_t)ROW_(ai, m) * 3072 + COLP_(bj)));
      UNR for (int m = 0; m < 4; ++m) { const int t = ROW_(ai, m);
        const float den = sRow[t] + sRow[256 + t] + sRow[512 + t] + sRow[768 + t] + sWin[t] * sQn[t];
        const float rden = __builtin_amdgcn_rcpf(fmaxf(fabsf(den), sEm[t])); float s1 = 0.f, s2 = 0.f;
        UNR for (int bj = 0; bj < 2; ++bj) { const u32x4 o4 = ov[m][bj];
          f32x4 v0 = acc[ai][bj][m][0] * rden, v1 = acc[ai][bj][m][1] * rden;
          v0[0] *= sigmoidf_(bflo(o4.x)); v0[1] *= sigmoidf_(bfhi(o4.x)); v0[2] *= sigmoidf_(bflo(o4.y)); v0[3] *= sigmoidf_(bfhi(o4.y));
          v1[0] *= sigmoidf_(bflo(o4.z)); v1[1] *= sigmoidf_(bfhi(o4.z)); v1[2] *= sigmoidf_(bflo(o4.w)); v1[3] *= sigmoidf_(bfhi(o4.w));
          acc[ai][bj][m][0] = v0; acc[ai][bj][m][1] = v1;
          s1 += v0[0] + v0[1] + v0[2] + v0[3] + v1[0] + v1[1] + v1[2] + v1[3];
          s2 += v0[0] * v0[0] + v0[1] * v0[1] + v0[2] * v0[2] + v0[3] * v0[3] + v1[0] * v1[0] + v1[1] * v1[1] + v1[2] * v1[2] + v1[3] * v1[3]; }
        s1 += __shfl_xor(s1, 16); s1 += __shfl_xor(s1, 32); s2 += __shfl_xor(s2, 16); s2 += __shfl_xor(s2, 32);
        if (fq == 0) { sR1[wc * 256 + t] = s1; sR2[wc * 256 + t] = s2; } }
      asm volatile("" : "+v"(acc[ai][0][0][0]), "+v"(acc[ai][0][1][0]), "+v"(acc[ai][0][2][0]), "+v"(acc[ai][0][3][0]) :: "memory"); } }
  __syncthreads();
  { RELANE; const u16* P3z = launder((const u16*)(p.ws + OFF_P3) + (size_t)tok0 * 3072 + 2048 + h * 256);
    u16* AM = launder((u16*)(p.ws + OFF_AM) + (size_t)tok0 * 1024 + h * 256); const float* gnp = launder(p.mgain + h * 256);
    f32x4 gn[2][2]; UNR for (int bj = 0; bj < 2; ++bj) { gn[bj][0] = *(const f32x4*)(gnp + COLP_(bj)); gn[bj][1] = *(const f32x4*)(gnp + COLP_(bj) + 4); }
    UNR for (int ai = 0; ai < 2; ++ai) { u32x4 zv[4][2];
      UNR for (int m = 0; m < 4; ++m) UNR for (int bj = 0; bj < 2; ++bj) zv[m][bj] = __builtin_nontemporal_load((const u32x4*)(P3z + (size_t)ROW_(ai, m) * 3072 + COLP_(bj)));
      UNR for (int m = 0; m < 4; ++m) { const int t = ROW_(ai, m);
        const float s1 = sR1[t] + sR1[256 + t] + sR1[512 + t] + sR1[768 + t], s2 = sR2[t] + sR2[256 + t] + sR2[512 + t] + sR2[768 + t];
        const float mu = s1 * (1.0f / 256.0f), var = fmaxf(s2 * (1.0f / 256.0f) - mu * mu, 0.f), rstd = rsqrtf(var + 1e-6f);
        UNR for (int bj = 0; bj < 2; ++bj) { const u32x4 z4 = zv[m][bj]; const f32x4 g0 = gn[bj][0], g1 = gn[bj][1]; const f32x4 v0 = acc[ai][bj][m][0], v1 = acc[ai][bj][m][1];
          const float y0 = (v0[0] - mu) * rstd * g0[0] * siluf_(bflo(z4.x)), y1 = (v0[1] - mu) * rstd * g0[1] * siluf_(bfhi(z4.x));
          const float y2 = (v0[2] - mu) * rstd * g0[2] * siluf_(bflo(z4.y)), y3 = (v0[3] - mu) * rstd * g0[3] * siluf_(bfhi(z4.y));
          const float y4 = (v1[0] - mu) * rstd * g1[0] * siluf_(bflo(z4.z)), y5 = (v1[1] - mu) * rstd * g1[1] * siluf_(bfhi(z4.z));
          const float y6 = (v1[2] - mu) * rstd * g1[2] * siluf_(bflo(z4.w)), y7 = (v1[3] - mu) * rstd * g1[3] * siluf_(bfhi(z4.w));
          u32x4 w; w.x = pk_bf16(y0, y1); w.y = pk_bf16(y2, y3); w.z = pk_bf16(y4, y5); w.w = pk_bf16(y6, y7); *(u32x4*)(AM + (size_t)t * 1024 + COLP_(bj)) = w; } }
      asm volatile("" ::: "memory"); } }
}

DEV void amerge_unit(const u16* __restrict__ OA, const float* __restrict__ LSE, const u16* __restrict__ P3, u16* __restrict__ AA, int u,
                     u32x4& a, u32x4& b, u32x4& c, u32x4& z, float& l0, float& l1, float& l2) {
  const int tok = u >> 7, c0 = (u & 127) * 8, h = c0 >> 7;
  l0 = LSE[(size_t)tok * 8 + h]; l1 = LSE[((size_t)NTOK + tok) * 8 + h]; l2 = LSE[((size_t)2 * NTOK + tok) * 8 + h];
  a = __builtin_nontemporal_load((const u32x4*)(OA + (size_t)tok * 1024 + c0)); b = __builtin_nontemporal_load((const u32x4*)(OA + ((size_t)NTOK + tok) * 1024 + c0)); c = __builtin_nontemporal_load((const u32x4*)(OA + ((size_t)2 * NTOK + tok) * 1024 + c0));
  z = __builtin_nontemporal_load((const u32x4*)(P3 + (size_t)tok * 3072 + c0));
}
DEV void amerge_fin(u16* __restrict__ AA, int u, const u32x4& a, const u32x4& b, const u32x4& c, const u32x4& z, float l0, float l1, float l2) {
  const int tok = u >> 7, c0 = (u & 127) * 8;
  const float mx = fmaxf(l0, fmaxf(l1, l2)); float w0 = __expf(l0 - mx), w1 = __expf(l1 - mx), w2 = __expf(l2 - mx);
  const float inv = __builtin_amdgcn_rcpf(w0 + w1 + w2); w0 *= inv; w1 *= inv; w2 *= inv;
  const unsigned au[4] = {a.x, a.y, a.z, a.w}, bu[4] = {b.x, b.y, b.z, b.w}, cu[4] = {c.x, c.y, c.z, c.w}, zu[4] = {z.x, z.y, z.z, z.w};
  unsigned o[4];
  UNR for (int e = 0; e < 4; ++e) {
    const float lo = (w0 * bflo(au[e]) + w1 * bflo(bu[e]) + w2 * bflo(cu[e])) * siluf_(bflo(zu[e]));
    const float hi = (w0 * bfhi(au[e]) + w1 * bfhi(bu[e]) + w2 * bfhi(cu[e])) * siluf_(bfhi(zu[e]));
    o[e] = pk_bf16(lo, hi); }
  u32x4 w; w.x = o[0]; w.y = o[1]; w.z = o[2]; w.w = o[3];
  *(u32x4*)(AA + (size_t)tok * 1024 + c0) = w;
}
DEV void phase_amerge(const Params& p) {
  const u16* OA = (const u16*)((char*)p.out + DO_OATT); const float* LSE = (const float*)(p.ws + OFF_LSE);
  const u16* P3 = (const u16*)(p.ws + OFF_P3); u16* AA = (u16*)(p.ws + OFF_AA);
  const int nthreads = gridDim.x * NTHR, N = NTOK * 128;
#pragma unroll 1
  for (int u = blockIdx.x * NTHR + ltid(); u < N; u += 4 * nthreads) {
    u32x4 a[4], b[4], c[4], z[4]; float l0[4], l1[4], l2[4];
    UNR for (int q = 0; q < 4; ++q) { const int uq = u + q * nthreads; if (uq < N) amerge_unit(OA, LSE, P3, AA, uq, a[q], b[q], c[q], z[q], l0[q], l1[q], l2[q]); }
    UNR for (int q = 0; q < 4; ++q) { const int uq = u + q * nthreads; if (uq < N) amerge_fin(AA, uq, a[q], b[q], c[q], z[q], l0[q], l1[q], l2[q]); }
  }
}
DEV void phase_d4(const Params& p, char* lds) {
  const bool merge_first = (blockIdx.x >> 3) & 1;
  if (merge_first) phase_amerge(p);
  for (int item = blockIdx.x; item < 256; item += gridDim.x) mout_item(p, lds, item);
#if PROBE_DUP == 22
  for (int item = blockIdx.x; item < 256; item += gridDim.x) mout_item(p, lds, item);
#endif
  if (!merge_first) phase_amerge(p);
#if PROBE_DUP == 23
  phase_amerge(p);
#endif
}

DEV size_t gate_off(int pm, int pg, int wid, int ai, int m, int bj, int lane) {
  return ((((((size_t)(pm * 16 + pg) * 8 + wid) * 2 + ai) * 4 + m) * 2 + bj) * 64 + lane) * 8;
}
DEV void phase_gemm_gates(const Params& p, char* lds) {
  const u16* H = (const u16*)(p.ws + OFF_H); const u16* W = (const u16*)(p.ws + OFF_WG); u16* P4 = (u16*)(p.ws + OFF_P4);
  gemm_stream(H, DM, W, DM, DM, 64, 16, (lchar*)lds, [=](const f32x4 (&acc)[2][2][4][2], int pm, int pn, int wr, int wc, int fr, int fq) {
    const int wid_ = wr * 4 + wc, lane_ = fq * 16 + fr;
    UNR for (int ai = 0; ai < 2; ++ai) UNR for (int m = 0; m < 4; ++m) {
      UNR for (int bj = 0; bj < 2; ++bj) { const f32x4 v0 = acc[ai][bj][m][0], v1 = acc[ai][bj][m][1]; u32x4 w;
        w.x = pk_bf16(sigmoidf_(v0[0]), sigmoidf_(v0[1])); w.y = pk_bf16(sigmoidf_(v0[2]), sigmoidf_(v0[3]));
        w.z = pk_bf16(sigmoidf_(v1[0]), sigmoidf_(v1[1])); w.w = pk_bf16(sigmoidf_(v1[2]), sigmoidf_(v1[3]));
        *(u32x4*)(P4 + gate_off(pm, pn, wid_, ai, m, bj, lane_)) = w; } }
  });
}

DEV void phase_gemm_merge(const Params& p, char* lds) {
  const u16* AA = (const u16*)(p.ws + OFF_AA); const u16* AM = (const u16*)(p.ws + OFF_AM);
  const u16* WA = (const u16*)(p.ws + OFF_WPA); const u16* WM = (const u16*)(p.ws + OFF_WPM);
  const u16* P4 = (const u16*)(p.ws + OFF_P4); u16* MG = (u16*)(p.ws + OFF_MG);
  gemm_stream2(AA, AM, 1024, WA, WM, 1024, 1024, 64, 8, (lchar*)lds, [=](f32x4 (&acc)[2][2][4][2], int pm, int pn, int seg, int wr, int wc) {
    RELANE; const u16* P4a = launder(P4); const int wid_ = wr * 4 + wc, lane_ = fq * 16 + fr;
    if (seg == 0) {
      UNR for (int ai = 0; ai < 2; ++ai) UNR for (int m = 0; m < 4; ++m) {
        UNR for (int bj = 0; bj < 2; ++bj) { const u32x4 ga = *(const u32x4*)(P4a + gate_off(pm, pn, wid_, ai, m, bj, lane_)), gb = *(const u32x4*)(P4a + gate_off(pm, 8 + pn, wid_, ai, m, bj, lane_));
          f32x4 v0 = acc[ai][bj][m][0], v1 = acc[ai][bj][m][1];
          v0[0] *= bflo(ga.x) * __builtin_amdgcn_rcpf(bflo(gb.x)); v0[1] *= bfhi(ga.x) * __builtin_amdgcn_rcpf(bfhi(gb.x)); v0[2] *= bflo(ga.y) * __builtin_amdgcn_rcpf(bflo(gb.y)); v0[3] *= bfhi(ga.y) * __builtin_amdgcn_rcpf(bfhi(gb.y));
          v1[0] *= bflo(ga.z) * __builtin_amdgcn_rcpf(bflo(gb.z)); v1[1] *= bfhi(ga.z) * __builtin_amdgcn_rcpf(bfhi(gb.z)); v1[2] *= bflo(ga.w) * __builtin_amdgcn_rcpf(bflo(gb.w)); v1[3] *= bfhi(ga.w) * __builtin_amdgcn_rcpf(bfhi(gb.w));
          acc[ai][bj][m][0] = v0; acc[ai][bj][m][1] = v1; }
        asm volatile("" : "+v"(acc[ai][0][m][0]), "+v"(acc[ai][0][m][1]), "+v"(acc[ai][1][m][0]), "+v"(acc[ai][1][m][1]) :: "memory"); }
    } else {
      UNR for (int ai = 0; ai < 2; ++ai) UNR for (int m = 0; m < 4; ++m) { const size_t ro = (size_t)(pm * 256 + ROW_(ai, m));
        UNR for (int bj = 0; bj < 2; ++bj) { const u32x4 gb = *(const u32x4*)(P4a + gate_off(pm, 8 + pn, wid_, ai, m, bj, lane_));
          const f32x4 v0 = acc[ai][bj][m][0], v1 = acc[ai][bj][m][1]; u32x4 w;
          w.x = pk_bf16(v0[0] * bflo(gb.x), v0[1] * bfhi(gb.x)); w.y = pk_bf16(v0[2] * bflo(gb.y), v0[3] * bfhi(gb.y));
          w.z = pk_bf16(v1[0] * bflo(gb.z), v1[1] * bfhi(gb.z)); w.w = pk_bf16(v1[2] * bflo(gb.w), v1[3] * bfhi(gb.w));
          *(u32x4*)(MG + ro * DM + pn * 256 + COLP_(bj)) = w; }
        asm volatile("" ::: "memory"); }
    }
  });
}

DEV void phase_gm(const Params& p, char* lds) {
  const u16* H = (const u16*)(p.ws + OFF_H); const u16* WG = (const u16*)(p.ws + OFF_WG);
  const u16* AA = (const u16*)(p.ws + OFF_AA); const u16* AM = (const u16*)(p.ws + OFF_AM);
  const u16* WA = (const u16*)(p.ws + OFF_WPA); const u16* WM = (const u16*)(p.ws + OFF_WPM);
  u16* P4 = (u16*)(p.ws + OFF_P4); u16* MG = (u16*)(p.ws + OFF_MG);
  gemm_stream_gm(H, WG, AA, AM, WA, WM, 64, 8, (lchar*)lds, [=](f32x4 (&acc)[2][2][4][2], int pm, int pn, int q, int wr, int wc) {
    RELANE; u16* P4a = launder(P4); const int wid_ = wr * 4 + wc, lane_ = fq * 16 + fr;
    if (q < 2) {
      UNR for (int ai = 0; ai < 2; ++ai) UNR for (int m = 0; m < 4; ++m) {
        UNR for (int bj = 0; bj < 2; ++bj) { const f32x4 v0 = acc[ai][bj][m][0], v1 = acc[ai][bj][m][1]; u32x4 w;
          w.x = pk_bf16(sigmoidf_(v0[0]), sigmoidf_(v0[1])); w.y = pk_bf16(sigmoidf_(v0[2]), sigmoidf_(v0[3]));
          w.z = pk_bf16(sigmoidf_(v1[0]), sigmoidf_(v1[1])); w.w = pk_bf16(sigmoidf_(v1[2]), sigmoidf_(v1[3]));
          *(u32x4*)(P4a + gate_off(pm, q * 8 + pn, wid_, ai, m, bj, lane_)) = w; } }
    } else if (q == 2) {
      UNR for (int ai = 0; ai < 2; ++ai) UNR for (int m = 0; m < 4; ++m) {
        UNR for (int bj = 0; bj < 2; ++bj) { const u32x4 ga = *(const u32x4*)(P4a + gate_off(pm, pn, wid_, ai, m, bj, lane_)), gb = *(const u32x4*)(P4a + gate_off(pm, 8 + pn, wid_, ai, m, bj, lane_));
          f32x4 v0 = acc[ai][bj][m][0], v1 = acc[ai][bj][m][1];
          v0[0] *= bflo(ga.x) * __builtin_amdgcn_rcpf(bflo(gb.x)); v0[1] *= bfhi(ga.x) * __builtin_amdgcn_rcpf(bfhi(gb.x)); v0[2] *= bflo(ga.y) * __builtin_amdgcn_rcpf(bflo(gb.y)); v0[3] *= bfhi(ga.y) * __builtin_amdgcn_rcpf(bfhi(gb.y));
          v1[0] *= bflo(ga.z) * __builtin_amdgcn_rcpf(bflo(gb.z)); v1[1] *= bfhi(ga.z) * __builtin_amdgcn_rcpf(bfhi(gb.z)); v1[2] *= bflo(ga.w) * __builtin_amdgcn_rcpf(bflo(gb.w)); v1[3] *= bfhi(ga.w) * __builtin_amdgcn_rcpf(bfhi(gb.w));
          acc[ai][bj][m][0] = v0; acc[ai][bj][m][1] = v1; }
        asm volatile("" : "+v"(acc[ai][0][m][0]), "+v"(acc[ai][0][m][1]), "+v"(acc[ai][1][m][0]), "+v"(acc[ai][1][m][1]) :: "memory"); }
    } else {
      UNR for (int ai = 0; ai < 2; ++ai) UNR for (int m = 0; m < 4; ++m) { const size_t ro = (size_t)(pm * 256 + ROW_(ai, m));
        UNR for (int bj = 0; bj < 2; ++bj) { const u32x4 gb = *(const u32x4*)(P4a + gate_off(pm, 8 + pn, wid_, ai, m, bj, lane_));
          const f32x4 v0 = acc[ai][bj][m][0], v1 = acc[ai][bj][m][1]; u32x4 w;
          w.x = pk_bf16(v0[0] * bflo(gb.x), v0[1] * bfhi(gb.x)); w.y = pk_bf16(v0[2] * bflo(gb.y), v0[3] * bfhi(gb.y));
          w.z = pk_bf16(v1[0] * bflo(gb.z), v1[1] * bfhi(gb.z)); w.w = pk_bf16(v1[2] * bflo(gb.w), v1[3] * bfhi(gb.w));
          *(u32x4*)(MG + ro * DM + pn * 256 + COLP_(bj)) = w; }
        asm volatile("" ::: "memory"); }
    }
  });
}

DEV void phase_gemm_out(const Params& p, char* lds) {
  const u16* MG = (const u16*)(p.ws + OFF_MG); const u16* WO = (const u16*)(p.ws + OFF_WOUT);
  const float* mod = (const float*)(p.ws + OFF_MOD); u16* DL = (u16*)(p.ws + OFF_DL);
  gemm_stream(MG, DM, WO, DM, DM, 64, 8, (lchar*)lds, [=](const f32x4 (&acc)[2][2][4][2], int pm, int pn, int wr, int wc, int fr, int fq) {
    const int b = (pm * 256) / SEQ;
    UNR for (int bj = 0; bj < 2; ++bj) { const int c0 = pn * 256 + COLP_(bj);
      const f32x4 g0 = *(const f32x4*)(mod + b * 6144 + 4096 + c0), g1 = *(const f32x4*)(mod + b * 6144 + 4096 + c0 + 4);
      UNR for (int ai = 0; ai < 2; ++ai) UNR for (int m = 0; m < 4; ++m) { const size_t ro = (size_t)(pm * 256 + ROW_(ai, m)) * DM + c0;
        const f32x4 v0 = g0 * acc[ai][bj][m][0], v1 = g1 * acc[ai][bj][m][1]; u32x4 w;
        w.x = pk_bf16(v0[0], v0[1]); w.y = pk_bf16(v0[2], v0[3]); w.z = pk_bf16(v1[0], v1[1]); w.w = pk_bf16(v1[2], v1[3]);
        *(u32x4*)(DL + ro) = w; } }
  });
}

DEV void phase_final(const Params& p) {
  const int wid = ltid() >> 6, lane = ltid() & 63;
  const u16* DL = (const u16*)(p.ws + OFF_DL);
#pragma unroll 1
  for (int row = (blockIdx.x * 8 + wid) * 2; row < NTOK; row += gridDim.x * 16) {
    const size_t ro = (size_t)row * DM + lane * 4;
    f32x4 xv[8], yv[8]; u32x2 dx[8], dy[8]; float ss = 0.f, st = 0.f;
    UNR for (int i = 0; i < 8; ++i) { xv[i] = *(const f32x4*)(p.x + ro + 256 * i); yv[i] = *(const f32x4*)(p.x + ro + DM + 256 * i);
      dx[i] = *(const u32x2*)(DL + ro + 256 * i); dy[i] = *(const u32x2*)(DL + ro + DM + 256 * i); }
    UNR for (int i = 0; i < 8; ++i) {
      xv[i][0] += bflo(dx[i].x); xv[i][1] += bfhi(dx[i].x); xv[i][2] += bflo(dx[i].y); xv[i][3] += bfhi(dx[i].y);
      yv[i][0] += bflo(dy[i].x); yv[i][1] += bfhi(dy[i].x); yv[i][2] += bflo(dy[i].y); yv[i][3] += bfhi(dy[i].y);
      ss += xv[i][0] * xv[i][0] + xv[i][1] * xv[i][1] + xv[i][2] * xv[i][2] + xv[i][3] * xv[i][3];
      st += yv[i][0] * yv[i][0] + yv[i][1] * yv[i][1] + yv[i][2] * yv[i][2] + yv[i][3] * yv[i][3]; }
    ss = wave_sum(ss); st = wave_sum(st);
    const float r0 = rsqrtf(ss * (1.0f / 2048.0f) + 1e-6f), r1 = rsqrtf(st * (1.0f / 2048.0f) + 1e-6f);
    UNR for (int i = 0; i < 8; ++i) { const f32x4 g = *(const f32x4*)(p.fgain + lane * 4 + 256 * i); *(f32x4*)(p.out + ro + 256 * i) = xv[i] * r0 * g; *(f32x4*)(p.out + ro + DM + 256 * i) = yv[i] * r1 * g; }
  }
}


#define XB_TMO      128
#define XB_XCNT(j)  (256  + 64 * (j))
#define XB_XSUB(j)  (1280 + 64 * (j))
#define XB_XGEN(j)  (2304 + 64 * (j))
#define XB_TOP      3328
#define XB_TOPGEN   3392
#define XCD_BAR_WORDS 3456
#define XB_SPIN_CAP (1u << 20)
DEV unsigned xb_ld(unsigned* p)              { return __hip_atomic_load(p, __ATOMIC_RELAXED, __HIP_MEMORY_SCOPE_AGENT); }
DEV unsigned xb_add(unsigned* p, unsigned v) { return __hip_atomic_fetch_add(p, v, __ATOMIC_RELAXED, __HIP_MEMORY_SCOPE_AGENT); }
DEV unsigned xb_xcc_id() { return (unsigned)__builtin_amdgcn_s_getreg((3 << 11) | 20) & 0xFu; }
#define XB_SPIN(cond, bar) do { unsigned _sp = 0; while (cond) { __builtin_amdgcn_s_sleep(1); \
    if ((++_sp & 255u) == 0u) { if (xb_ld(&(bar)[XB_TMO])) break; if (_sp > XB_SPIN_CAP) { atomicAdd(&(bar)[XB_TMO], 1u); break; } } } } while (0)
struct XcdBarrier { unsigned* bar; unsigned x; volatile LAS unsigned* st; };
DEV XcdBarrier xcd_barrier_post(unsigned* bar, volatile LAS unsigned* st) {
  XcdBarrier b; b.bar = bar; b.x = xb_xcc_id(); b.st = st;
  if (threadIdx_x_raw() == 0) (void)xb_add(&bar[XB_XCNT(b.x)], 1u);
  return b;
}
DEV void xcd_barrier_complete(unsigned* bar, unsigned x, unsigned& nloc, unsigned& nx) {
  const unsigned G = gridDim.x;
  unsigned sum, cnt, mine, sp = 0u;
  for (;;) {
    sum = 0u; cnt = 0u; mine = 0u;
#pragma unroll
    for (unsigned j = 0; j < 16; ++j) { const unsigned c = xb_ld(&bar[XB_XCNT(j)]); sum += c; cnt += (c > 0u) ? 1u : 0u; mine = (j == x) ? c : mine; }
    if (sum == G) break;
    __builtin_amdgcn_s_sleep(1);
    if ((++sp & 255u) == 0u) { if (xb_ld(&bar[XB_TMO])) break; if (sp > XB_SPIN_CAP) { atomicAdd(&bar[XB_TMO], 1u); break; } }
  }
  nloc = mine > 0u ? mine : 1u; nx = cnt > 0u ? cnt : 1u;
}
DEV void xcd_barrier(const XcdBarrier& b) {
  asm volatile("s_waitcnt vmcnt(0)" ::: "memory");
  __syncthreads();
  if (threadIdx_x_raw() == 0) {
    unsigned* bar = b.bar;
    __builtin_amdgcn_s_waitcnt(0);
    unsigned nloc = b.st[0], nx = b.st[1];
    if (nloc == 0u) { xcd_barrier_complete(bar, b.x, nloc, nx); b.st[0] = nloc; b.st[1] = nx; }
    const unsigned old = xb_add(&bar[XB_XSUB(b.x)], 1u);
    const unsigned gen = old / nloc;
    if (old + 1u == (gen + 1u) * nloc) {
      __builtin_amdgcn_fence(__ATOMIC_RELEASE, "agent");
      asm volatile("s_waitcnt vmcnt(0)" ::: "memory");
      const unsigned og = xb_add(&bar[XB_TOP], 1u);
      const unsigned tg = og / nx;
      if (og + 1u == (tg + 1u) * nx) xb_add(&bar[XB_TOPGEN], 1u);
      else XB_SPIN(xb_ld(&bar[XB_TOPGEN]) == tg, bar);
      __builtin_amdgcn_fence(__ATOMIC_ACQUIRE, "agent");
      xb_add(&bar[XB_XGEN(b.x)], 1u);
      asm volatile("s_waitcnt vmcnt(0)" ::: "memory");
    } else {
      XB_SPIN(xb_ld(&bar[XB_XGEN(b.x)]) == gen, bar);
      __builtin_amdgcn_fence(__ATOMIC_ACQUIRE, "agent");
      asm volatile("s_waitcnt vmcnt(0)" ::: "memory");
    }
  }
  __syncthreads();
}

constexpr int NPHASE = 11;
#ifndef ONE_LAUNCH
#define ONE_LAUNCH 1
#endif
#if ONE_LAUNCH
__global__ void __launch_bounds__(NTHR, 2) mega(Params p) {
  extern __shared__ __attribute__((aligned(16))) char lds[];
  cg::grid_group grid = cg::this_grid();
  volatile LAS unsigned* st = (volatile LAS unsigned*)((lchar*)lds + OFF_LDS_ST);
  if (threadIdx_x_raw() == 0) { st[0] = 0u; st[1] = 0u; }
  __syncthreads();
  const XcdBarrier xb = xcd_barrier_post((unsigned*)(p.ws + OFF_BAR), st);
  if (p.ws == nullptr) grid.sync();
  phase_prep(p, lds); xcd_barrier(xb);
  phase_h(p, lds); xcd_barrier(xb);
#if PROBE_DUP == 8
  phase_prep(p, lds); xcd_barrier(xb);
#endif
#if PROBE_DUP == 9
  phase_h(p, lds); xcd_barrier(xb);
#endif
#if PROBE_DUP == 4
  phase_prep(p, lds); xcd_barrier(xb); phase_h(p, lds); xcd_barrier(xb);
#endif
  phase_gemm_main(p, lds); xcd_barrier(xb);
#if PROBE_DUP == 1
  phase_gemm_main(p, lds); xcd_barrier(xb);
#endif
  phase_d1(p, lds); xcd_barrier(xb);
#if PROBE_DUP == 2
  phase_d1(p, lds); xcd_barrier(xb);
#endif
  phase_scan(p, lds); xcd_barrier(xb);
  phase_d4(p, lds); xcd_barrier(xb);
#if PROBE_DUP == 11
  phase_scan(p, lds); xcd_barrier(xb);
#endif
#if PROBE_DUP == 12
  phase_d4(p, lds); xcd_barrier(xb);
#endif
#if PROBE_DUP == 3
  phase_scan(p, lds); xcd_barrier(xb); phase_d4(p, lds); xcd_barrier(xb);
#endif
#if USE_GM
  phase_gm(p, lds); xcd_barrier(xb);
#else
  phase_gemm_gates(p, lds); xcd_barrier(xb);
#if PROBE_DUP == 5
  phase_gemm_gates(p, lds); xcd_barrier(xb);
#endif
  phase_gemm_merge(p, lds); xcd_barrier(xb);
#endif
#if PROBE_DUP == 6
  phase_gemm_merge(p, lds); xcd_barrier(xb);
#endif
  phase_gemm_out(p, lds); xcd_barrier(xb);
#if PROBE_DUP == 7
  phase_gemm_out(p, lds); xcd_barrier(xb);
#endif
  phase_final(p);
#if PROBE_DUP == 24
  xcd_barrier(xb); phase_final(p);
#endif
}
#define MEGA_FN mega
static void setattr_all() {}
#else
template <int PH> __global__ void __launch_bounds__(NTHR, 2) phk(Params p) {
  extern __shared__ __attribute__((aligned(16))) char lds[];
  if (PH == 0) phase_prep(p, lds);
  if (PH == 1) phase_h(p, lds);
  if (PH == 2) phase_gemm_main(p, lds);
  if (PH == 3) phase_d1(p, lds);
  if (PH == 4) { }
  if (PH == 5) phase_scan(p, lds);
  if (PH == 6) phase_d4(p, lds);
  if (PH == 7) phase_gemm_gates(p, lds);
  if (PH == 8) phase_gemm_merge(p, lds);
  if (PH == 9) phase_gemm_out(p, lds);
  if (PH == 10) phase_final(p);
}
#define MEGA_FN phk<2>
template <int PH> static void setattr_ph() { (void)hipFuncSetAttribute((const void*)phk<PH>, hipFuncAttributeMaxDynamicSharedMemorySize, LDS_BYTES); }
static void setattr_all() { setattr_ph<0>(); setattr_ph<1>(); setattr_ph<2>(); setattr_ph<3>(); setattr_ph<4>(); setattr_ph<5>(); setattr_ph<6>(); setattr_ph<7>(); setattr_ph<8>(); setattr_ph<9>(); setattr_ph<10>(); }
template <int PH> static void launch_ph(const Params& p, int grid, hipStream_t stream) {
  phk<PH><<<dim3(grid), dim3(NTHR), LDS_BYTES, stream>>>(p);
}
#endif

extern "C" void kernel_launch(void* const* d_in, const int* in_sizes, int n_in, void* d_out, int out_size, void* d_ws, size_t ws_size, hipStream_t stream) {
  static int grid = 0;
  if (!grid) {
    if (ws_size < WS_NEED || out_size != NTOK * DM || n_in != 14) { fprintf(stderr, "kernel_launch: unexpected sizes (ws %zu need %zu)\n", ws_size, (size_t)WS_NEED); grid = -1; return; }
    int dev = 0, cus = 0, per_cu = 0;
    (void)hipGetDevice(&dev); (void)hipDeviceGetAttribute(&cus, hipDeviceAttributeMultiprocessorCount, dev);
    (void)hipFuncSetAttribute((const void*)MEGA_FN, hipFuncAttributeMaxDynamicSharedMemorySize, LDS_BYTES); setattr_all();
    (void)hipOccupancyMaxActiveBlocksPerMultiprocessor(&per_cu, (const void*)MEGA_FN, NTHR, LDS_BYTES);
    if (per_cu < 1) { fprintf(stderr, "kernel_launch: occupancy query says 0 blocks per CU\n"); grid = -1; return; }
    grid = cus;
  }
  if (grid < 0) return;
  Params p{};
  p.x = (const float*)d_in[0]; p.c = (const float*)d_in[1]; p.norm_gain = (const float*)d_in[2]; p.w_ada = (const float*)d_in[3]; p.b_ada = (const float*)d_in[4];
  p.w_in = (const float*)d_in[5]; p.b_gate_if = (const float*)d_in[6]; p.conv_w = (const float*)d_in[7]; p.conv_b = (const float*)d_in[8]; p.mgain = (const float*)d_in[9];
  p.w_pa = (const float*)d_in[10]; p.w_pm = (const float*)d_in[11]; p.w_out = (const float*)d_in[12]; p.fgain = (const float*)d_in[13];
  p.out = (float*)d_out; p.ws = (char*)d_ws;
#if ONE_LAUNCH
  (void)hipMemsetAsync((char*)d_ws + OFF_BAR, 0, XCD_BAR_WORDS * 4, stream);
  void* args[] = {&p};
  hipError_t e = hipLaunchCooperativeKernel((const void*)mega, dim3(grid), dim3(NTHR), args, LDS_BYTES, stream);
  if (e != hipSuccess) fprintf(stderr, "cooperative launch failed: %s\n", hipGetErrorString(e));
#else
  launch_ph<0>(p, grid, stream); launch_ph<1>(p, grid, stream); launch_ph<2>(p, grid, stream); launch_ph<3>(p, grid, stream);
  launch_ph<4>(p, grid, stream); launch_ph<5>(p, grid, stream); launch_ph<6>(p, grid, stream); launch_ph<7>(p, grid, stream);
  launch_ph<8>(p, grid, stream); launch_ph<9>(p, grid, stream); launch_ph<10>(p, grid, stream);
#endif
}
```

```cpp
#include <hip/hip_runtime.h>
#include <hip/hip_cooperative_groups.h>
#include <cstdio>
#include <cstdint>
namespace cg = cooperative_groups;

typedef unsigned short u16;
typedef short bf16x8 __attribute__((ext_vector_type(8)));
typedef float f32x4 __attribute__((ext_vector_type(4)));
typedef unsigned u32x4 __attribute__((ext_vector_type(4)));
typedef unsigned u32x2 __attribute__((ext_vector_type(2)));

#define PROBE_DUP 0
#define USE_GM 1
#define DEV __device__ __forceinline__
__device__ __forceinline__ int threadIdx_x_raw() { return (int)threadIdx.x; }
DEV int ltid() { int t = threadIdx_x_raw(); asm volatile("" : "+v"(t)); return t; }
#define UNR _Pragma("unroll")
#define RELANE int l_ = ltid() & 63; asm volatile("" : "+v"(l_)); const int fr = l_ & 15, fq = l_ >> 4; (void)fr; (void)fq
template <class T> __device__ __forceinline__ T* launder(T* p) { asm volatile("" : "+s"(p)); return p; }

constexpr int NTOK = 16384, DM = 2048, SEQ = 8192, INC = 13320;
constexpr int NTHR = 512;
constexpr int LDS_BYTES = 159744;
constexpr size_t MBy = 1ull << 20;
constexpr size_t OFF_MODP = 576 * 1024;
constexpr size_t OFF_MOD = 0, OFF_BAR = 49152, OFF_IFG = 64 * 1024, OFF_LSE = 1 * MBy;
constexpr int OFF_LDS_ST = 159488;
constexpr size_t OFF_SA = 2 * MBy + 512 * 1024, OFF_SC = OFF_SA + 256 * 1024, OFF_SCM = OFF_SC + 256 * 1024;
constexpr size_t OFF_IA = 3 * MBy + 256 * 1024, OFF_IG = OFF_IA + 4096, OFF_MK = OFF_IG + 4096;
constexpr size_t OFF_NU = 3 * MBy + 512 * 1024, OFF_NK = OFF_NU + 256 * 1024;
constexpr size_t OFF_WPA = 4 * MBy, OFF_WPM = 8 * MBy, OFF_WOUT = 12 * MBy, OFF_WG = 20 * MBy, OFF_WMAIN = 36 * MBy;
constexpr size_t OFF_H = 72 * MBy, OFF_P3 = 136 * MBy, OFF_P1 = 232 * MBy, OFF_P2 = 328 * MBy;
constexpr size_t OFF_QC = 424 * MBy, OFF_KC = 456 * MBy, WS_NEED = 488 * MBy;
constexpr size_t OFF_KWT = OFF_WMAIN;
constexpr size_t OFF_U = 232 * MBy, OFF_CT = 296 * MBy, OFF_PB = 328 * MBy, OFF_AA = 360 * MBy, OFF_AM = 392 * MBy;
constexpr size_t OFF_P4 = 232 * MBy;
constexpr size_t OFF_MG = 424 * MBy;
constexpr size_t OFF_DL = 360 * MBy;
constexpr size_t DO_OATT = 0, DO_VT = 96 * MBy;

struct Params {
  const float *x, *c, *norm_gain, *w_ada, *b_ada, *w_in, *b_gate_if, *conv_w, *conv_b, *mgain, *w_pa, *w_pm, *w_out, *fgain;
  float* out; char* ws;
};

DEV float bf2f(u16 v) { return __uint_as_float(((unsigned)v) << 16); }
DEV float bflo(unsigned u) { return __uint_as_float(u << 16); }
DEV float bfhi(unsigned u) { return __uint_as_float(u & 0xffff0000u); }
typedef float f32x2_ __attribute__((ext_vector_type(2)));
typedef __bf16 bf16x2_ __attribute__((ext_vector_type(2)));
DEV unsigned pk_bf16(float lo, float hi) { f32x2_ v = {lo, hi}; bf16x2_ b = __builtin_convertvector(v, bf16x2_); return __builtin_bit_cast(unsigned, b); }
DEV float sigmoidf_(float v) { return __builtin_amdgcn_rcpf(1.0f + __expf(-v)); }
DEV float siluf_(float v) { return v * __builtin_amdgcn_rcpf(1.0f + __expf(-v)); }
DEV float wave_sum(float v) {
  v += __int_as_float(__builtin_amdgcn_update_dpp(0, __float_as_int(v), 0xB1, 0xf, 0xf, true));
  v += __int_as_float(__builtin_amdgcn_update_dpp(0, __float_as_int(v), 0x4E, 0xf, 0xf, true));
  v += __int_as_float(__builtin_amdgcn_update_dpp(0, __float_as_int(v), 0x141, 0xf, 0xf, true));
  v += __int_as_float(__builtin_amdgcn_update_dpp(0, __float_as_int(v), 0x140, 0xf, 0xf, true));
  return __int_as_float(__builtin_amdgcn_readlane(__float_as_int(v), 0)) + __int_as_float(__builtin_amdgcn_readlane(__float_as_int(v), 16)) +
         __int_as_float(__builtin_amdgcn_readlane(__float_as_int(v), 32)) + __int_as_float(__builtin_amdgcn_readlane(__float_as_int(v), 48));
}
DEV int perm32(int rho) { const int n = rho >> 4, i = rho & 15; return 8 * (i >> 2) + 4 * n + (i & 3); }

constexpr int BK = 64, HALF = 128, HT = HALF * BK;
DEV int lds_byte(int r, int c) { int st = (r >> 4) * 2 + (c >> 5), rr = r & 15, cc = c & 31, ob = rr * 64 + cc * 2; return st * 1024 + (ob ^ (((ob >> 9) & 1) << 5)); }
DEV void stage_rc(int b, int& R, int& C) { int st = b / 1024, sb = b % 1024, swz = sb ^ (((sb >> 9) & 1) << 5); R = (st >> 1) * 16 + swz / 64; C = (st & 1) * 32 + (swz % 64) / 2; }

#define LAS __attribute__((address_space(3)))
typedef LAS char lchar;
constexpr int HTB = HT * 2;
#define SA_(b, h) (((b) * 2 + (h)) * HTB)
#define SB_(b, h) ((4 + (b) * 2 + (h)) * HTB)
#define STAGE(bufoff, gbase, voff) do { _Pragma("unroll") for (int _i = 0; _i < 2; ++_i) \
    __builtin_amdgcn_global_load_lds((const unsigned*)((const char*)(gbase) + (voff)[_i]), (LAS unsigned*)(lds + (bufoff) + ldsw + _i * 8192), 16, 0, 0); } while (0)
#define LDA(dst, b, h) do { _Pragma("unroll") for (int m = 0; m < 4; ++m) _Pragma("unroll") for (int k = 0; k < 2; ++k) dst[m][k] = *(const LAS bf16x8*)(lds + SA_(b, h) + aoff + m * 2048 + k * 1024); } while (0)
#define LDB(dst, b, h) do { _Pragma("unroll") for (int n = 0; n < 2; ++n) _Pragma("unroll") for (int k = 0; k < 2; ++k) dst[n][k] = *(const LAS bf16x8*)(lds + SB_(b, h) + boff + n * 2048 + k * 1024); } while (0)
#define MMA(ai, bj, At, Bx) do { __builtin_amdgcn_s_setprio(1); _Pragma("unroll") for (int m = 0; m < 4; ++m) _Pragma("unroll") for (int n = 0; n < 2; ++n) _Pragma("unroll") for (int k = 0; k < 2; ++k) \
      acc[ai][bj][m][n] = __builtin_amdgcn_mfma_f32_16x16x32_bf16(Bx[n][k], At[m][k], acc[ai][bj][m][n], 0, 0, 0); \
    __builtin_amdgcn_s_setprio(0); } while (0)
#define WAIT_V(n) asm volatile("s_waitcnt vmcnt(" #n ")" ::: "memory")
#define WAIT_L(n) asm volatile("s_waitcnt lgkmcnt(" #n ")" ::: "memory")
#define BAR __builtin_amdgcn_s_barrier()
#define SCHED __builtin_amdgcn_sched_barrier(0)

DEV void gemm_kloop(f32x4 (&acc)[2][2][4][2], const u16* A, int lda, const u16* Bt, int ldb, int K, lchar* lds) {
  const int tid = ltid(), wid = __builtin_amdgcn_readfirstlane(tid >> 6), lane = tid & 63, wr = wid >> 2, wc = wid & 3, fr = lane & 15, fq = lane >> 4;
  unsigned voffA[2], voffB[2];
#pragma unroll
  for (int i = 0; i < 2; ++i) { int R, C; stage_rc(tid * 16 + i * 8192, R, C); const int Rb = (R & ~31) + perm32(R & 31); voffA[i] = (unsigned)(R * lda + C) * 2u; voffB[i] = (unsigned)(Rb * ldb + C) * 2u; }
  const size_t kstep = (size_t)(BK * 2), hA = (size_t)HALF * lda * 2, hB = (size_t)HALF * ldb * 2;
  const unsigned ldsw = (unsigned)wid * 1024u;
  const int aoff = lds_byte(wr * 64 + fr, fq * 8), boff = lds_byte(wc * 32 + fr, fq * 8);
  const char* cA = (const char*)A; const char* cB = (const char*)Bt;
  bf16x8 At[4][2], B0[2][2], B1[2][2];
  const int nt = K / BK;
  STAGE(SB_(0, 0), cB, voffB); STAGE(SA_(0, 0), cA, voffA); STAGE(SB_(0, 1), cB + hB, voffB); STAGE(SA_(0, 1), cA + hA, voffA);
  if (wr == 1) BAR;
  WAIT_V(4); BAR;
  STAGE(SB_(1, 0), cB + kstep, voffB); STAGE(SA_(1, 0), cA + kstep, voffA); STAGE(SB_(1, 1), cB + hB + kstep, voffB);
  WAIT_V(6); BAR;
  for (int t = 0; t < nt - 2; t += 2) {
    const char* a1 = cA + (size_t)(t + 1) * kstep; const char* a2 = a1 + kstep; const char* a3 = a2 + kstep;
    const char* b2 = cB + (size_t)(t + 2) * kstep; const char* b3 = b2 + kstep;
    LDB(B0, 0, 0); SCHED; LDA(At, 0, 0); STAGE(SA_(1, 1), a1 + hA, voffA);
    WAIT_L(8); BAR; WAIT_L(0); MMA(0, 0, At, B0); BAR; SCHED;
    LDB(B1, 0, 1); STAGE(SB_(0, 0), b2, voffB);
    BAR; WAIT_L(0); MMA(0, 1, At, B1); BAR;
    LDA(At, 0, 1); STAGE(SA_(0, 0), a2, voffA);
    BAR; WAIT_L(0); MMA(1, 0, At, B0); BAR; SCHED;
    STAGE(SB_(0, 1), b2 + hB, voffB);
    WAIT_V(6); BAR; MMA(1, 1, At, B1); BAR;
    LDB(B0, 1, 0); SCHED; LDA(At, 1, 0); STAGE(SA_(0, 1), a2 + hA, voffA);
    WAIT_L(8); BAR; WAIT_L(0); MMA(0, 0, At, B0); BAR; SCHED;
    LDB(B1, 1, 1); STAGE(SB_(1, 0), b3, voffB);
    BAR; WAIT_L(0); MMA(0, 1, At, B1); BAR;
    LDA(At, 1, 1); STAGE(SA_(1, 0), a3, voffA);
    BAR; WAIT_L(0); MMA(1, 0, At, B0); BAR; SCHED;
    STAGE(SB_(1, 1), b3 + hB, voffB);
    WAIT_V(6); BAR; MMA(1, 1, At, B1); BAR;
  }
  { LDB(B0, 0, 0); LDA(At, 0, 0); STAGE(SA_(1, 1), cA + (size_t)(nt - 1) * kstep + hA, voffA);
    BAR; WAIT_L(0); MMA(0, 0, At, B0); BAR;
    LDB(B1, 0, 1); BAR; WAIT_L(0); MMA(0, 1, At, B1); BAR;
    LDA(At, 0, 1); WAIT_V(4); BAR; WAIT_L(0); MMA(1, 0, At, B0); MMA(1, 1, At, B1); BAR; }
  { LDB(B0, 1, 0); LDA(At, 1, 0); WAIT_V(2); BAR; WAIT_L(0); MMA(0, 0, At, B0); BAR;
    LDB(B1, 1, 1); WAIT_V(0); BAR; WAIT_L(0); MMA(0, 1, At, B1); BAR;
    LDA(At, 1, 1); BAR; WAIT_L(0); MMA(1, 0, At, B0); MMA(1, 1, At, B1); BAR; }
  if (wr == 0) BAR;
}

DEV void acc_zero(f32x4 (&acc)[2][2][4][2]) {
  _Pragma("unroll") for (int a = 0; a < 2; ++a) _Pragma("unroll") for (int b = 0; b < 2; ++b) _Pragma("unroll") for (int m = 0; m < 4; ++m) _Pragma("unroll") for (int n = 0; n < 2; ++n) acc[a][b][m][n] = (f32x4){0.f, 0.f, 0.f, 0.f};
}
DEV bool tile_next(int i, int nM, int nN, int& pm, int& pn) {
  const int nwg = nM * nN; const long L = (long)i * gridDim.x + blockIdx.x; if (L >= nwg) return false;
  int wgid = (int)L; { const int q = nwg / 8, r = nwg % 8, xcd = wgid % 8, off = wgid / 8; wgid = (xcd < r ? xcd * (q + 1) : r * (q + 1) + (xcd - r) * q) + off; }
  const int nig = 8 * nN, gid = wgid / nig, fm = gid * 8, gsz = (nM - fm) < 8 ? (nM - fm) : 8;
  pm = fm + ((wgid % nig) % gsz); pn = (wgid % nig) / gsz; return true;
}
template <class Epi>
DEV void gemm_stream(const u16* A, int lda, const u16* Bt, int ldb, int K, int nM, int nN, lchar* lds, Epi&& epi) {
  const int tid = ltid(), wid = __builtin_amdgcn_readfirstlane(tid >> 6), lane = tid & 63, wr = wid >> 2, wc = wid & 3, fr = lane & 15, fq = lane >> 4;
  int pm, pn, npm, npn, ui = 0;
  if (!tile_next(0, nM, nN, pm, pn)) return;
  unsigned voffA[2], voffB[2];
#pragma unroll
  for (int i = 0; i < 2; ++i) { int R, C; stage_rc(tid * 16 + i * 8192, R, C); voffA[i] = (unsigned)(R * lda + C) * 2u; voffB[i] = (unsigned)(R * ldb + C) * 2u; }
  const size_t kstep = (size_t)(BK * 2), hA = (size_t)HALF * lda * 2, hB = (size_t)HALF * ldb * 2, tA = 2 * hA, tB = 2 * hB;
  const unsigned ldsw = (unsigned)wid * 1024u;
  const int aoff = lds_byte(wr * 64 + fr, fq * 8), boff = lds_byte(wc * 32 + fr, fq * 8);
  const int nt = K / BK;
  f32x4 acc[2][2][4][2]; acc_zero(acc);
  bf16x8 At[4][2], B0[2][2], B1[2][2];
  const char* cA = (const char*)A + (size_t)pm * tA; const char* cB = (const char*)Bt + (size_t)pn * tB;
  STAGE(SB_(0, 0), cB, voffB); STAGE(SB_(0, 1), cB + hB, voffB); STAGE(SA_(0, 0), cA, voffA); STAGE(SA_(0, 1), cA + hA, voffA);
  if (wr == 1) BAR;
  WAIT_V(2); BAR;
  STAGE(SB_(1, 0), cB + kstep, voffB); STAGE(SA_(1, 0), cA + kstep, voffA); STAGE(SB_(1, 1), cB + hB + kstep, voffB);
  WAIT_V(6); BAR;
  for (;;) {
    const bool has_next = tile_next(ui + 1, nM, nN, npm, npn);
    const char* nA = has_next ? (const char*)A + (size_t)npm * tA : cA; const char* nB = has_next ? (const char*)Bt + (size_t)npn * tB : cB;
    for (int t = 0; t < nt; t += 2) {
      const bool last = (t == nt - 2);
      const char* a1 = cA + (size_t)(t + 1) * kstep;
      const char* a2 = last ? nA : cA + (size_t)(t + 2) * kstep; const char* b2 = last ? nB : cB + (size_t)(t + 2) * kstep;
      const char* a3 = a2 + kstep; const char* b3 = b2 + kstep;
      LDB(B0, 0, 0); LDB(B1, 0, 1); SCHED; LDA(At, 0, 0); STAGE(SA_(1, 1), a1 + hA, voffA);
      WAIT_V(8); WAIT_L(0); BAR; MMA(0, 0, At, B0); MMA(0, 1, At, B1); BAR; SCHED;
      LDA(At, 0, 1); STAGE(SB_(0, 0), b2, voffB); STAGE(SB_(0, 1), b2 + hB, voffB); STAGE(SA_(0, 0), a2, voffA);
      WAIT_V(8); WAIT_L(0); BAR; MMA(1, 0, At, B0); MMA(1, 1, At, B1); BAR; SCHED;
      LDB(B0, 1, 0); LDB(B1, 1, 1); SCHED; LDA(At, 1, 0); STAGE(SA_(0, 1), a2 + hA, voffA);
      WAIT_V(8); WAIT_L(0); BAR; MMA(0, 0, At, B0); MMA(0, 1, At, B1); BAR; SCHED;
      LDA(At, 1, 1); STAGE(SB_(1, 0), b3, voffB); STAGE(SB_(1, 1), b3 + hB, voffB); STAGE(SA_(1, 0), a3, voffA);
      WAIT_V(8); WAIT_L(0); BAR; MMA(1, 0, At, B0); MMA(1, 1, At, B1); BAR; SCHED;
    }
    if (wr == 0) BAR;
    epi(acc, pm, pn, wr, wc, fr, fq);
    if (!has_next) break;
    acc_zero(acc);
    pm = npm; pn = npn; cA = nA; cB = nB; ++ui;
    if (wr == 1) BAR;
  }
  WAIT_V(0);
  BAR;
}

template <class Epi>
DEV void gemm_stream2(const u16* A0, const u16* A1, int lda, const u16* B0p, const u16* B1p, int ldb, int K, int nM, int nN, lchar* lds, Epi&& epi) {
  const int tid = ltid(), wid = __builtin_amdgcn_readfirstlane(tid >> 6), lane = tid & 63, wr = wid >> 2, wc = wid & 3, fr = lane & 15, fq = lane >> 4;
  int pm, pn, npm, npn, ui = 0;
  if (!tile_next(0, nM, nN, pm, pn)) return;
  unsigned voffA[2], voffB[2];
#pragma unroll
  for (int i = 0; i < 2; ++i) { int R, C; stage_rc(tid * 16 + i * 8192, R, C); voffA[i] = (unsigned)(R * lda + C) * 2u; voffB[i] = (unsigned)(R * ldb + C) * 2u; }
  const size_t kstep = (size_t)(BK * 2), hA = (size_t)HALF * lda * 2, hB = (size_t)HALF * ldb * 2, tA = 2 * hA, tB = 2 * hB;
  const unsigned ldsw = (unsigned)wid * 1024u;
  const int aoff = lds_byte(wr * 64 + fr, fq * 8), boff = lds_byte(wc * 32 + fr, fq * 8);
  const int nt = K / BK;
  f32x4 acc[2][2][4][2]; acc_zero(acc);
  bf16x8 At[4][2], B0[2][2], B1[2][2];
  const char* cA = (const char*)A0 + (size_t)pm * tA; const char* cB = (const char*)B0p + (size_t)pn * tB;
  STAGE(SB_(0, 0), cB, voffB); STAGE(SB_(0, 1), cB + hB, voffB); STAGE(SA_(0, 0), cA, voffA); STAGE(SA_(0, 1), cA + hA, voffA);
  if (wr == 1) BAR;
  WAIT_V(2); BAR;
  STAGE(SB_(1, 0), cB + kstep, voffB); STAGE(SA_(1, 0), cA + kstep, voffA); STAGE(SB_(1, 1), cB + hB + kstep, voffB);
  WAIT_V(6); BAR;
  for (;;) {
    const int seg = ui & 1;
    bool has_next = true; npm = pm; npn = pn;
    if (seg) has_next = tile_next((ui >> 1) + 1, nM, nN, npm, npn);
    const char* nA = has_next ? (const char*)(seg ? A0 : A1) + (size_t)npm * tA : cA; const char* nB = has_next ? (const char*)(seg ? B0p : B1p) + (size_t)npn * tB : cB;
    for (int t = 0; t < nt; t += 2) {
      const bool last = (t == nt - 2);
      const char* a1 = cA + (size_t)(t + 1) * kstep;
      const char* a2 = last ? nA : cA + (size_t)(t + 2) * kstep; const char* b2 = last ? nB : cB + (size_t)(t + 2) * kstep;
      const char* a3 = a2 + kstep; const char* b3 = b2 + kstep;
      LDB(B0, 0, 0); LDB(B1, 0, 1); SCHED; LDA(At, 0, 0); STAGE(SA_(1, 1), a1 + hA, voffA);
      WAIT_V(8); WAIT_L(0); BAR; MMA(0, 0, At, B0); MMA(0, 1, At, B1); BAR; SCHED;
      LDA(At, 0, 1); STAGE(SB_(0, 0), b2, voffB); STAGE(SB_(0, 1), b2 + hB, voffB); STAGE(SA_(0, 0), a2, voffA);
      WAIT_V(8); WAIT_L(0); BAR; MMA(1, 0, At, B0); MMA(1, 1, At, B1); BAR; SCHED;
      LDB(B0, 1, 0); LDB(B1, 1, 1); SCHED; LDA(At, 1, 0); STAGE(SA_(0, 1), a2 + hA, voffA);
      WAIT_V(8); WAIT_L(0); BAR; MMA(0, 0, At, B0); MMA(0, 1, At, B1); BAR; SCHED;
      LDA(At, 1, 1); STAGE(SB_(1, 0), b3, voffB); STAGE(SB_(1, 1), b3 + hB, voffB); STAGE(SA_(1, 0), a3, voffA);
      WAIT_V(8); WAIT_L(0); BAR; MMA(1, 0, At, B0); MMA(1, 1, At, B1); BAR; SCHED;
    }
    if (wr == 0) BAR;
    epi(acc, pm, pn, seg, wr, wc);
    if (!has_next) break;
    if (seg) acc_zero(acc);
    pm = npm; pn = npn; cA = nA; cB = nB; ++ui;
    if (wr == 1) BAR;
  }
  WAIT_V(0);
  BAR;
}

#define STAGE2(bufoff, gbase, lg) do { \
    __builtin_amdgcn_global_load_lds((const unsigned*)((const char*)(gbase) + ((lg) ? vL0 : vS0)), (LAS unsigned*)(lds + (bufoff) + ldsw), 16, 0, 0); \
    __builtin_amdgcn_global_load_lds((const unsigned*)((const char*)(gbase) + ((lg) ? vL1 : vS1)), (LAS unsigned*)(lds + (bufoff) + ldsw + 8192), 16, 0, 0); } while (0)
template <class Epi>
DEV void gemm_stream_gm(const u16* H, const u16* WG, const u16* AA, const u16* AM, const u16* WA, const u16* WM, int nM, int nN, lchar* lds, Epi&& epi) {
  const int tid = ltid(), wid = __builtin_amdgcn_readfirstlane(tid >> 6), lane = tid & 63, wr = wid >> 2, wc = wid & 3, fr = lane & 15, fq = lane >> 4;
  int pm, pn, npm, npn, ui = 0;
  if (!tile_next(0, nM, nN, pm, pn)) return;
  unsigned vL0, vL1, vS0, vS1;
  { int R, C; stage_rc(tid * 16, R, C); vL0 = (unsigned)(R * 2048 + C) * 2u; vS0 = (unsigned)(R * 1024 + C) * 2u;
    stage_rc(tid * 16 + 8192, R, C); vL1 = (unsigned)(R * 2048 + C) * 2u; vS1 = (unsigned)(R * 1024 + C) * 2u; }
  const size_t kstep = (size_t)(BK * 2), hL = (size_t)HALF * 2048 * 2, hS = (size_t)HALF * 1024 * 2;
  const unsigned ldsw = (unsigned)wid * 1024u;
  const int aoff = lds_byte(wr * 64 + fr, fq * 8), boff = lds_byte(wc * 32 + fr, fq * 8);
  f32x4 acc[2][2][4][2]; acc_zero(acc);
  bf16x8 At[4][2], B0[2][2], B1[2][2];
#define GM_A(q, tpm) ((q) < 2 ? (const char*)H + (size_t)(tpm) * 256 * 2048 * 2 : (const char*)((q) == 2 ? AA : AM) + (size_t)(tpm) * 256 * 1024 * 2)
#define GM_B(q, tpn) ((q) < 2 ? (const char*)WG + ((size_t)(q) * 2048 + (size_t)(tpn) * 256) * 2048 * 2 : (const char*)((q) == 2 ? WA : WM) + (size_t)(tpn) * 256 * 1024 * 2)
  const char* cA = GM_A(0, pm); const char* cB = GM_B(0, pn);
  STAGE2(SB_(0, 0), cB, true); STAGE2(SB_(0, 1), cB + hL, true); STAGE2(SA_(0, 0), cA, true); STAGE2(SA_(0, 1), cA + hL, true);
  if (wr == 1) BAR;
  WAIT_V(2); BAR;
  STAGE2(SB_(1, 0), cB + kstep, true); STAGE2(SA_(1, 0), cA + kstep, true); STAGE2(SB_(1, 1), cB + hL + kstep, true);
  WAIT_V(6); BAR;
  bool has_next = true;
#define GM_UNIT(Q, NA, NB) do { \
    const char* nA = (NA); const char* nB = (NB); \
    constexpr bool cl = (Q) < 2, nl = (((Q) + 1) & 3) < 2; constexpr int nt = cl ? 32 : 16; \
    const size_t ch = cl ? hL : hS; \
    for (int t = 0; t < nt; t += 2) { \
      const bool last = (t == nt - 2); \
      const char* a1 = cA + (size_t)(t + 1) * kstep; \
      const char* a2 = last ? nA : cA + (size_t)(t + 2) * kstep; const char* b2 = last ? nB : cB + (size_t)(t + 2) * kstep; \
      const char* a3 = a2 + kstep; const char* b3 = b2 + kstep; \
      const bool wl = last ? nl : cl; const size_t h2 = wl ? hL : hS; \
      LDB(B0, 0, 0); LDB(B1, 0, 1); SCHED; LDA(At, 0, 0); STAGE2(SA_(1, 1), a1 + ch, cl); \
      WAIT_V(8); WAIT_L(0); BAR; MMA(0, 0, At, B0); MMA(0, 1, At, B1); BAR; SCHED; \
      LDA(At, 0, 1); STAGE2(SB_(0, 0), b2, wl); STAGE2(SB_(0, 1), b2 + h2, wl); STAGE2(SA_(0, 0), a2, wl); \
      WAIT_V(8); WAIT_L(0); BAR; MMA(1, 0, At, B0); MMA(1, 1, At, B1); BAR; SCHED; \
      LDB(B0, 1, 0); LDB(B1, 1, 1); SCHED; LDA(At, 1, 0); STAGE2(SA_(0, 1), a2 + h2, wl); \
      WAIT_V(8); WAIT_L(0); BAR; MMA(0, 0, At, B0); MMA(0, 1, At, B1); BAR; SCHED; \
      LDA(At, 1, 1); STAGE2(SB_(1, 0), b3, wl); STAGE2(SB_(1, 1), b3 + h2, wl); STAGE2(SA_(1, 0), a3, wl); \
      WAIT_V(8); WAIT_L(0); BAR; MMA(1, 0, At, B0); MMA(1, 1, At, B1); BAR; SCHED; \
    } \
    if (wr == 0) BAR; \
    epi(acc, pm, pn, (Q), wr, wc); \
    cA = nA; cB = nB; } while (0)
  for (;;) {
    GM_UNIT(0, GM_A(1, pm), GM_B(1, pn)); acc_zero(acc); if (wr == 1) BAR;
    GM_UNIT(1, GM_A(2, pm), GM_B(2, pn)); acc_zero(acc); if (wr == 1) BAR;
    GM_UNIT(2, GM_A(3, pm), GM_B(3, pn)); if (wr == 1) BAR;
    has_next = tile_next(ui + 1, nM, nN, npm, npn);
    GM_UNIT(3, has_next ? GM_A(0, npm) : cA, has_next ? GM_B(0, npn) : cB);
    if (!has_next) break;
    acc_zero(acc); pm = npm; pn = npn; ++ui;
    if (wr == 1) BAR;
  }
  WAIT_V(0);
  BAR;
#undef GM_UNIT
#undef GM_A
#undef GM_B
}

#define ROW_(ai, m) (128 * (ai) + 64 * wr + 16 * (m) + fr)
#define COLP_(bj) (128 * (bj) + 32 * wc + 8 * fq)
#define COLN_(bj, n) (128 * (bj) + 32 * wc + 16 * (n) + 4 * fq)
#define WLANE const int wid = __builtin_amdgcn_readfirstlane(ltid() >> 6), lane = ltid() & 63, wr = wid >> 2, wc = wid & 3, fr = lane & 15, fq = lane >> 4; (void)wid; (void)lane; (void)wr; (void)wc; (void)fr; (void)fq

DEV void phase_prep(const Params& p, char* lds) {
  const int tid = ltid(), wid = tid >> 6, lane = tid & 63;
  float* fl = (float*)lds;
  for (int job = blockIdx.x; job < 192; job += gridDim.x) {
    const int cgp = job % 24, kp = job / 24;
    __syncthreads();
    fl[tid] = p.c[(tid >> 8) * 2048 + kp * 256 + (tid & 255)];
    __syncthreads();
    f32x4 a0 = {0.f, 0.f, 0.f, 0.f}, a1 = {0.f, 0.f, 0.f, 0.f};
    const float* wp = p.w_ada + (size_t)(kp * 256 + wid) * 6144 + cgp * 256 + lane * 4;
#pragma unroll 8
    for (int it = 0; it < 32; ++it) { const f32x4 w = __builtin_nontemporal_load((const f32x4*)(wp + (size_t)it * 8 * 6144)); const int kk = it * 8 + wid; a0 += w * fl[kk]; a1 += w * fl[256 + kk]; }
    float* red = fl + 512;
    *(f32x4*)(red + (wid * 2 + 0) * 256 + lane * 4) = a0; *(f32x4*)(red + (wid * 2 + 1) * 256 + lane * 4) = a1;
    __syncthreads();
    { const int bb = tid >> 8, cc = tid & 255; float s = 0.f;
      UNR for (int w = 0; w < 8; ++w) s += red[(w * 2 + bb) * 256 + cc];
      ((float*)(p.ws + OFF_MODP))[(size_t)(kp * 2 + bb) * 6144 + cgp * 256 + cc] = s; }
  }
  constexpr int T_MAIN = 144 * 32, T_G = 64 * 32, T_PA = 32 * 16, T_PM = 32 * 16, T_OUT = 32 * 32;
  constexpr int T_ALL = T_MAIN + T_G + T_PA + T_PM + T_OUT;
  for (int jg = blockIdx.x; jg < T_ALL / 4; jg += gridDim.x) {
    const float* src; int ld, K, nt_, kt_, scol; u16* dst; int j = jg * 4;
    if (j < T_MAIN) { nt_ = j / 32; kt_ = j % 32; src = p.w_in; ld = INC; K = 2048; dst = (u16*)(p.ws + OFF_WMAIN);
      const int cp = nt_ * 64; scol = cp < 3072 ? cp : (cp < 6144 ? cp + 1024 : (cp < 7168 ? cp - 3072 : cp)); }
    else if ((j -= T_MAIN) < T_G) { nt_ = j / 32; kt_ = j % 32; src = p.w_in; ld = INC; K = 2048; dst = (u16*)(p.ws + OFF_WG); scol = 9224 + nt_ * 64; }
    else if ((j -= T_G) < T_PA) { nt_ = j / 16; kt_ = j % 16; src = p.w_pa; ld = 2048; K = 1024; dst = (u16*)(p.ws + OFF_WPA); scol = nt_ * 64; }
    else if ((j -= T_PA) < T_PM) { nt_ = j / 16; kt_ = j % 16; src = p.w_pm; ld = 2048; K = 1024; dst = (u16*)(p.ws + OFF_WPM); scol = nt_ * 64; }
    else { j -= T_PM; nt_ = j / 32; kt_ = j % 32; src = p.w_out; ld = 2048; K = 2048; dst = (u16*)(p.ws + OFF_WOUT); scol = nt_ * 64; }
    __syncthreads();
    { const int r = tid >> 4, c4 = (tid & 15) * 4;
      const float* g = src + (size_t)(kt_ * 64 + r) * ld + scol + c4;
      f32x4 v[8];
      UNR for (int q = 0; q < 8; ++q) v[q] = __builtin_nontemporal_load((const f32x4*)(g + (size_t)q * 32 * ld));
      UNR for (int q = 0; q < 8; ++q) { float* t = fl + (q >> 1) * 4160 + ((q & 1) * 32 + r) * 65 + c4; t[0] = v[q][0]; t[1] = v[q][1]; t[2] = v[q][2]; t[3] = v[q][3]; } }
    __syncthreads();
    { const int nrow = tid >> 3, k8 = tid & 7; const int ncol = (nrow & 32) + perm32(nrow & 31);
      UNR for (int t = 0; t < 4; ++t) {
        float v[8]; UNR for (int jj = 0; jj < 8; ++jj) v[jj] = fl[t * 4160 + (k8 * 8 + jj) * 65 + ncol];
        u32x4 w; w.x = pk_bf16(v[0], v[1]); w.y = pk_bf16(v[2], v[3]); w.z = pk_bf16(v[4], v[5]); w.w = pk_bf16(v[6], v[7]);
        *(u32x4*)(dst + (size_t)(nt_ * 64 + nrow) * K + (kt_ + t) * 64 + k8 * 8) = w; } }
  }
}

DEV void phase_h(const Params& p, char* lds) {
  const int tid = ltid(), wid = tid >> 6, lane = tid & 63;
  float* gsc = (float*)lds; float* sh = gsc + 2048; float* wif = sh + 2048;
  const float* modp = (const float*)(p.ws + OFF_MODP);
  u16* H = (u16*)(p.ws + OFF_H); float* IFG = (float*)(p.ws + OFF_IFG);
  for (int rb = blockIdx.x; rb < NTOK / 64; rb += gridDim.x) {
    const int b = (rb * 64) / SEQ;
    __syncthreads();
    for (int i = tid; i < 2048; i += NTHR) { float s0 = p.b_ada[i], s1 = p.b_ada[2048 + i];
      UNR for (int kp = 0; kp < 8; ++kp) { s0 += modp[(size_t)(kp * 2 + b) * 6144 + i]; s1 += modp[(size_t)(kp * 2 + b) * 6144 + 2048 + i]; }
      gsc[i] = p.norm_gain[i] * (1.0f + s1); sh[i] = s0; }
    if ((rb & 127) == 0) for (int i = tid; i < 2048; i += NTHR) { float s2 = p.b_ada[4096 + i];
      UNR for (int kp = 0; kp < 8; ++kp) s2 += modp[(size_t)(kp * 2 + b) * 6144 + 4096 + i];
      ((float*)(p.ws + OFF_MOD))[b * 6144 + 4096 + i] = s2; }
    for (int i = tid; i < 4096; i += NTHR) { const int k = i >> 1, hf = i & 1; const f32x4 wv4 = *(const f32x4*)(p.w_in + (size_t)k * INC + 9216 + hf * 4);
      UNR for (int e = 0; e < 4; ++e) wif[(hf * 4 + e) * 2048 + k] = wv4[e]; }
    __syncthreads();
    const float* xr0 = p.x + (size_t)(rb * 64 + wid * 8) * DM + lane * 4;
    f32x4 xn[8];
    UNR for (int i = 0; i < 8; ++i) xn[i] = __builtin_nontemporal_load((const f32x4*)(xr0 + 256 * i));
#pragma unroll 1
    for (int rr = 0; rr < 8; ++rr) {
      const int row = rb * 64 + wid * 8 + rr;
      f32x4 xv[8]; float ss = 0.f;
      UNR for (int i = 0; i < 8; ++i) { xv[i] = xn[i]; ss += xv[i][0] * xv[i][0] + xv[i][1] * xv[i][1] + xv[i][2] * xv[i][2] + xv[i][3] * xv[i][3]; }
      if (rr < 7) { UNR for (int i = 0; i < 8; ++i) xn[i] = __builtin_nontemporal_load((const f32x4*)(xr0 + (size_t)(rr + 1) * DM + 256 * i)); }
      ss = wave_sum(ss);
      const float rstd = rsqrtf(ss * (1.0f / 2048.0f) + 1e-6f);
      float a[8]; UNR for (int j = 0; j < 8; ++j) a[j] = 0.f;
      UNR for (int i = 0; i < 8; ++i) { const int c0 = lane * 4 + 256 * i;
        const f32x4 gv = *(const f32x4*)(gsc + c0), sv = *(const f32x4*)(sh + c0);
        const f32x4 hv = xv[i] * rstd * gv + sv;
        UNR for (int j = 0; j < 8; ++j) { const f32x4 wj = *(const f32x4*)(wif + j * 2048 + c0); a[j] += hv[0] * wj[0] + hv[1] * wj[1] + hv[2] * wj[2] + hv[3] * wj[3]; }
        u32x2 w; w.x = pk_bf16(hv[0], hv[1]); w.y = pk_bf16(hv[2], hv[3]);
        *(u32x2*)(H + (size_t)row * DM + c0) = w;
        asm volatile("" ::: "memory"); }
      UNR for (int j = 0; j < 8; ++j) a[j] = wave_sum(a[j]);
      if (lane < 8) { float v = a[0]; for (int j = 1; j < 8; ++j) v = (lane == j) ? a[j] : v; IFG[(size_t)row * 8 + lane] = v + p.b_gate_if[lane]; }
    }
  }
}

DEV void phase_gemm_main(const Params& p, char* lds) {
  const u16* H = (const u16*)(p.ws + OFF_H); const u16* W = (const u16*)(p.ws + OFF_WMAIN); char* ws = p.ws;
  gemm_stream(H, DM, W, DM, DM, 64, 36, (lchar*)lds, [=](const f32x4 (&acc)[2][2][4][2], int pm, int pn, int wr, int wc, int fr, int fq) {
    const int cb = pn * 256, buf = cb / 3072, cc = cb % 3072;
    u16* O = (u16*)(ws + (buf == 0 ? OFF_P1 : (buf == 1 ? OFF_P2 : OFF_P3)));
    UNR for (int ai = 0; ai < 2; ++ai) UNR for (int m = 0; m < 4; ++m) { u16* rp = O + (size_t)(pm * 256 + ROW_(ai, m)) * 3072 + cc;
      UNR for (int bj = 0; bj < 2; ++bj) { const f32x4 v0 = acc[ai][bj][m][0], v1 = acc[ai][bj][m][1]; u32x4 w;
        w.x = pk_bf16(v0[0], v0[1]); w.y = pk_bf16(v0[2], v0[3]); w.z = pk_bf16(v1[0], v1[1]); w.w = pk_bf16(v1[2], v1[3]);
        __builtin_nontemporal_store(w, (u32x4*)(rp + COLP_(bj))); } }
  });
}

template <int OFF> DEV u32x2 tr_read(unsigned addr) { u32x2 r; asm volatile("ds_read_b64_tr_b16 %0, %1 offset:%2" : "=&v"(r) : "v"(addr), "i"(OFF) : "memory"); return r; }
#define TR2(c) v0[c] = tr_read<(c) * 32>(vb); v1[c] = tr_read<1088 + (c) * 32>(vb);
constexpr int ABUF = 69632, AVOFF = 34816;
DEV void attn_chunk(const Params& p, char* lds_, int ci) {
  lchar* lds = (lchar*)lds_;
  const int tid = ltid(), wid = __builtin_amdgcn_readfirstlane(tid >> 6), lane = tid & 63, fr = lane & 15, g = lane >> 4;
  const int pat = ci >> 8, rem = ci & 255;
  const int d = pat == 0 ? 1 : (pat == 1 ? 4 : 16), cps = 16 / d;
  const int cpos = rem % cps, stream = rem / cps, r = stream % d, bh = stream / d, b = bh >> 3, h = bh & 7;
  const int n0 = cpos * 4;
  const u16* P1 = (const u16*)(p.ws + OFF_P1) + (size_t)b * SEQ * 3072 + h * 128;
  const int lrow = tid >> 4, lch = tid & 15;
  u32x4 kreg[4], vreg[4];
  __syncthreads();
  const int qi = 16 * wid + fr;
  bf16x8 qn[4];
  { u32x4 kr2[4], vr2[4];
    if (n0 > 0) {
      UNR for (int ps = 0; ps < 4; ++ps) { const int tk = ((n0 - 1) * 128 + lrow + 32 * ps) * d + r; const u16* s = P1 + (size_t)tk * 3072 + lch * 8; kreg[ps] = *(const u32x4*)(s + 1024); vreg[ps] = *(const u32x4*)(s + 2048); }
    } else {
      UNR for (int ps = 0; ps < 4; ++ps) { kreg[ps] = (u32x4){0u, 0u, 0u, 0u}; vreg[ps] = (u32x4){0u, 0u, 0u, 0u}; }
    }
    UNR for (int ps = 0; ps < 4; ++ps) { const int tk = (n0 * 128 + lrow + 32 * ps) * d + r; const u16* s = P1 + (size_t)tk * 3072 + lch * 8; kr2[ps] = *(const u32x4*)(s + 1024); vr2[ps] = *(const u32x4*)(s + 2048); }
    { const u16* qp = P1 + (size_t)((n0 * 128 + qi) * d + r) * 3072 + 8 * g;
      UNR for (int s = 0; s < 4; ++s) qn[s] = *(const bf16x8*)(qp + 32 * s); }
    UNR for (int ps = 0; ps < 4; ++ps) { *(LAS u32x4*)(lds + (lrow + 32 * ps) * 272 + lch * 16) = kreg[ps]; *(LAS u32x4*)(lds + AVOFF + (lrow + 32 * ps) * 272 + lch * 16) = vreg[ps]; }
    UNR for (int ps = 0; ps < 4; ++ps) { *(LAS u32x4*)(lds + ABUF + (lrow + 32 * ps) * 272 + lch * 16) = kr2[ps]; *(LAS u32x4*)(lds + ABUF + AVOFF + (lrow + 32 * ps) * 272 + lch * 16) = vr2[ps]; } }
  __syncthreads();
  const float c1 = 0.08838834764831845f * 1.4426950408889634f, c2 = exp2f(-(float)(h + 1)) * (float)d * 1.4426950408889634f;
#pragma unroll 1
  for (int i = 0; i < 4; ++i) {
    const int nq = n0 + i;
    lchar* prevB = lds + (i & 1) * ABUF; lchar* curB = lds + ((i + 1) & 1) * ABUF;
    const int tq = (nq * 128 + qi) * d + r;
    bf16x8 qf[4];
    UNR for (int s = 0; s < 4; ++s) qf[s] = qn[s];
    if (i < 3) {
      UNR for (int ps = 0; ps < 4; ++ps) { const int tk = ((nq + 1) * 128 + lrow + 32 * ps) * d + r; const u16* s = P1 + (size_t)tk * 3072 + lch * 8; kreg[ps] = *(const u32x4*)(s + 1024); vreg[ps] = *(const u32x4*)(s + 2048); }
      const u16* qp = P1 + (size_t)(((nq + 1) * 128 + qi) * d + r) * 3072 + 8 * g;
      UNR for (int s = 0; s < 4; ++s) qn[s] = *(const bf16x8*)(qp + 32 * s);
    }
    const int u = wid >> 1;
    int gofs[5];
#pragma unroll
    for (int kq = 0; kq < 5; ++kq) { const int ks = u + kq; gofs[kq] = (((ks < 4) ? (i & 1) : ((i + 1) & 1)) * ABUF) + (ks & 3) * 8704; }
    f32x4 sc[5][2];
    { const int koff = (8 * (fr >> 2) + (fr & 3)) * 272 + 16 * g;
      bf16x8 kfa[8], kfb[8];
#pragma unroll
      for (int q = 0; q < 8; ++q) kfa[q] = *(const LAS bf16x8*)(lds + gofs[0] + koff + (q >> 2) * 1088 + 64 * (q & 3));
#pragma unroll
      for (int kq = 0; kq < 5; ++kq) {
        if (kq < 4) {
#pragma unroll
          for (int q = 0; q < 8; ++q) { const bf16x8 v = *(const LAS bf16x8*)(lds + gofs[kq + 1] + koff + (q >> 2) * 1088 + 64 * (q & 3)); if (kq & 1) kfa[q] = v; else kfb[q] = v; }
        }
        SCHED;
#pragma unroll
        for (int t = 0; t < 2; ++t) {
          f32x4 a = {0.f, 0.f, 0.f, 0.f};
#pragma unroll
          for (int s = 0; s < 4; ++s) a = __builtin_amdgcn_mfma_f32_16x16x32_bf16((kq & 1) ? kfb[t * 4 + s] : kfa[t * 4 + s], qf[s], a, 0, 0, 0);
          sc[kq][t] = a;
        }
        SCHED;
      } }
    const int dbl = 16 * (wid & 1) + fr - 8 * g + 128;
    const float b0 = -c2 * (float)dbl;
    float mx = -INFINITY;
#pragma unroll
    for (int kq = 0; kq < 5; ++kq) {
      const bool gval = (nq > 0) || (u + kq >= 4);
#pragma unroll
      for (int t = 0; t < 2; ++t) {
#pragma unroll
        for (int j = 0; j < 4; ++j) {
          const int kk = 32 * kq + 4 * t + j;
          float s = __builtin_fmaf(sc[kq][t][j], c1, __builtin_fmaf(c2, (float)kk, b0));
          bool valid = gval;
          if (kq == 0) valid = valid && (dbl - kk <= 128);
          if (kq == 4) valid = valid && (dbl - kk >= 0);
          s = valid ? s : -INFINITY;
          sc[kq][t][j] = s; mx = fmaxf(mx, s);
        } } }
    mx = fmaxf(mx, __shfl_xor(mx, 16)); mx = fmaxf(mx, __shfl_xor(mx, 32));
    float sum = 0.f;
#pragma unroll
    for (int kq = 0; kq < 5; ++kq) {
#pragma unroll
      for (int t = 0; t < 2; ++t) {
#pragma unroll
        for (int j = 0; j < 4; ++j) { const float e = __builtin_amdgcn_exp2f(sc[kq][t][j] - mx); sc[kq][t][j] = e; sum += e; } } }
    sum += __shfl_xor(sum, 16); sum += __shfl_xor(sum, 32);
    const float inv = __builtin_amdgcn_rcpf(sum);
    f32x4 oc[8];
#pragma unroll
    for (int c = 0; c < 8; ++c) oc[c] = (f32x4){0.f, 0.f, 0.f, 0.f};
    const unsigned vlane = (unsigned)(size_t)lds + AVOFF + (8 * g + (fr >> 2)) * 272 + 8 * (fr & 3);
    u32x2 va0[8], va1[8], vb0[8], vb1[8];
#define TRA(c) va0[c] = tr_read<(c) * 32>(vb); va1[c] = tr_read<1088 + (c) * 32>(vb);
#define TRB(c) vb0[c] = tr_read<(c) * 32>(vb); vb1[c] = tr_read<1088 + (c) * 32>(vb);
    { const unsigned vb = vlane + gofs[0]; TRA(0) TRA(1) TRA(2) TRA(3) TRA(4) TRA(5) TRA(6) TRA(7) }
#pragma unroll
    for (int kq = 0; kq < 5; ++kq) {
      union { bf16x8 v; unsigned u[4]; } pf;
      pf.u[0] = pk_bf16(sc[kq][0][0], sc[kq][0][1]); pf.u[1] = pk_bf16(sc[kq][0][2], sc[kq][0][3]);
      pf.u[2] = pk_bf16(sc[kq][1][0], sc[kq][1][1]); pf.u[3] = pk_bf16(sc[kq][1][2], sc[kq][1][3]);
      asm volatile("s_waitcnt lgkmcnt(0)" ::: "memory"); SCHED;
      if (kq < 4) { const unsigned vb = vlane + gofs[kq + 1];
        if (kq & 1) { TRA(0) TRA(1) TRA(2) TRA(3) TRA(4) TRA(5) TRA(6) TRA(7) } else { TRB(0) TRB(1) TRB(2) TRB(3) TRB(4) TRB(5) TRB(6) TRB(7) } }
#pragma unroll
      for (int c = 0; c < 8; ++c) {
        union { bf16x8 v; unsigned u[4]; } vf;
        if (kq & 1) { vf.u[0] = vb0[c].x; vf.u[1] = vb0[c].y; vf.u[2] = vb1[c].x; vf.u[3] = vb1[c].y; }
        else { vf.u[0] = va0[c].x; vf.u[1] = va0[c].y; vf.u[2] = va1[c].x; vf.u[3] = va1[c].y; }
        oc[c] = __builtin_amdgcn_mfma_f32_16x16x32_bf16(vf.v, pf.v, oc[c], 0, 0, 0);
      }
    }
    { u16* O = (u16*)((char*)p.out + DO_OATT) + ((size_t)pat * NTOK + (size_t)(b * SEQ + tq)) * 1024 + h * 128 + 4 * g;
#pragma unroll
      for (int c = 0; c < 8; ++c) { u32x2 w; w.x = pk_bf16(oc[c][0] * inv, oc[c][1] * inv); w.y = pk_bf16(oc[c][2] * inv, oc[c][3] * inv); *(u32x2*)(O + 16 * c) = w; }
      if (g == 0) ((float*)(p.ws + OFF_LSE))[((size_t)pat * NTOK + (size_t)(b * SEQ + tq)) * 8 + h] = (mx + __builtin_amdgcn_logf(sum)) * 0.6931471805599453f; }
    __syncthreads();
    if (i < 3) {
      UNR for (int ps = 0; ps < 4; ++ps) { *(LAS u32x4*)(prevB + (lrow + 32 * ps) * 272 + lch * 16) = kreg[ps]; *(LAS u32x4*)(prevB + AVOFF + (lrow + 32 * ps) * 272 + lch * 16) = vreg[ps]; }
    }
    __syncthreads();
  }
}

DEV void mprep_item(const Params& p, char* lds, int item) {
  const int tid = ltid();
  const int k = item & 31, h = (item >> 5) & 3, b = item >> 7;
  const int tok0 = b * SEQ + k * 256;
  char* Ts = lds;
  float* sa = (float*)(lds + 135168); float* sb = sa + 256; float* sw = sb + 256; float* red = sw + 256;
  const float* IFG = (const float*)(p.ws + OFF_IFG);
  const u16* P2 = (const u16*)(p.ws + OFF_P2);
  __syncthreads();
  float iv = 0.f, av = 0.f, cv = 0.f;
  if (tid < 256) { const float f = IFG[(size_t)(tok0 + tid) * 8 + 4 + h]; iv = IFG[(size_t)(tok0 + tid) * 8 + h];
    av = fminf(f, 0.f) - log1pf(__expf(-fabsf(f))); sa[tid] = av; }
  __syncthreads();
  for (int off = 1; off < 256; off <<= 1) { float t = 0.f; if (tid < 256 && tid >= off) t = sa[tid - off]; __syncthreads(); if (tid < 256) { av += t; sa[tid] = av; } __syncthreads(); }
  if (tid < 256) { cv = iv - av; sb[tid] = cv; }
  float cm = cv;
  __syncthreads();
  for (int off = 1; off < 256; off <<= 1) { float t = -INFINITY; if (tid < 256 && tid >= off) t = sb[tid - off]; __syncthreads(); if (tid < 256) { cm = fmaxf(cm, t); sb[tid] = cm; } __syncthreads(); }
  const float cmall = sb[255], Aall = sa[255];
  if (tid < 256) { const size_t ix = (size_t)(tok0 + tid) * 4 + h;
    ((float*)(p.ws + OFF_SA))[ix] = av; ((float*)(p.ws + OFF_SC))[ix] = cv; ((float*)(p.ws + OFF_SCM))[ix] = cm;
    sw[tid] = __expf(cv - cmall); }
  if (tid == 0) { ((float*)(p.ws + OFF_IA))[item] = Aall; ((float*)(p.ws + OFF_IG))[item] = Aall + cmall; }
  __syncthreads();
  u16* QC = (u16*)(p.ws + OFF_QC); u16* KC = (u16*)(p.ws + OFF_KC);
  float* nup = red;
  { const int cgp = tid & 31, rg = tid >> 5, e0 = cgp * 8, ch = h * 256 + e0, t0 = rg * 16;
#pragma unroll 1
    for (int pass = 0; pass < 2; ++pass) {
      const int wofs = pass * 1024 + ch;
      float wv[4][8], bv[8];
      UNR for (int e = 0; e < 8; ++e) bv[e] = p.conv_b[wofs + e];
      UNR for (int j = 0; j < 4; ++j) { UNR for (int e = 0; e < 8; ++e) wv[j][e] = p.conv_w[(size_t)j * 2048 + wofs + e]; }
      float ns[8]; UNR for (int e = 0; e < 8; ++e) ns[e] = 0.f;
#pragma unroll 1
      for (int half = 0; half < 2; ++half) {
      u32x4 rows[11];
      UNR for (int i = 0; i < 11; ++i) { const int pos = k * 256 + t0 + half * 8 + i - 3;
        rows[i] = (pos >= 0) ? __builtin_nontemporal_load((const u32x4*)(P2 + (size_t)(tok0 + t0 + half * 8 + i - 3) * 3072 + pass * 1024 + ch)) : (u32x4){0u, 0u, 0u, 0u}; }
      UNR for (int i = 0; i < 8; ++i) {
        float acc8[8]; UNR for (int e = 0; e < 8; ++e) acc8[e] = bv[e];
        UNR for (int j = 0; j < 4; ++j) { const u32x4 rv = rows[i + j]; const unsigned ru[4] = {rv.x, rv.y, rv.z, rv.w};
          UNR for (int e = 0; e < 4; ++e) { acc8[2 * e] += wv[j][2 * e] * bflo(ru[e]); acc8[2 * e + 1] += wv[j][2 * e + 1] * bfhi(ru[e]); } }
        const int t = t0 + half * 8 + i;
        if (pass == 0) {
          UNR for (int e = 0; e < 8; ++e) acc8[e] = siluf_(acc8[e]);
          u32x4 o; o.x = pk_bf16(acc8[0], acc8[1]); o.y = pk_bf16(acc8[2], acc8[3]); o.z = pk_bf16(acc8[4], acc8[5]); o.w = pk_bf16(acc8[6], acc8[7]);
          *(u32x4*)(QC + (size_t)(tok0 + t) * 1024 + ch) = o;
        } else {
          const float w = sw[t]; float kw[8];
          UNR for (int e = 0; e < 8; ++e) { acc8[e] = siluf_(acc8[e]) * 0.0625f; kw[e] = acc8[e] * w; }
          u32x4 o; o.x = pk_bf16(acc8[0], acc8[1]); o.y = pk_bf16(acc8[2], acc8[3]); o.z = pk_bf16(acc8[4], acc8[5]); o.w = pk_bf16(acc8[6], acc8[7]);
          *(u32x4*)(KC + (size_t)(tok0 + t) * 1024 + ch) = o;
          o.x = pk_bf16(kw[0], kw[1]); o.y = pk_bf16(kw[2], kw[3]); o.z = pk_bf16(kw[4], kw[5]); o.w = pk_bf16(kw[6], kw[7]);
          *(u32x4*)(Ts + t * 528 + e0 * 2) = o;
          const unsigned ou[4] = {o.x, o.y, o.z, o.w};
          UNR for (int e = 0; e < 4; ++e) { ns[2 * e] += bflo(ou[e]); ns[2 * e + 1] += bfhi(ou[e]); }
        }
        asm volatile("" ::: "memory");
      }
      }
      if (pass == 1) { *(f32x4*)(nup + rg * 256 + e0) = (f32x4){ns[0], ns[1], ns[2], ns[3]}; *(f32x4*)(nup + rg * 256 + e0 + 4) = (f32x4){ns[4], ns[5], ns[6], ns[7]}; }
    } }
  __syncthreads();
  const int wid = __builtin_amdgcn_readfirstlane(tid >> 6), lane = tid & 63, li = lane & 15, lg = lane >> 4;
  const unsigned trl = (unsigned)(size_t)(lchar*)lds + (8 * lg + (li >> 2)) * 528 + 8 * (li & 3);
  { u16* KWT = (u16*)(p.ws + OFF_KWT) + (size_t)item * 65536;
#pragma unroll 1
    for (int j4 = 0; j4 < 4; ++j4) { u32x2 ra[4], rb[4];
      UNR for (int q = 0; q < 4; ++q) { const int uq = wid * 16 + j4 * 4 + q, eb = (uq & 15) * 16, sb2 = (uq >> 4) * 32; const unsigned ad = trl + sb2 * 528 + eb * 2;
        ra[q] = tr_read<0>(ad); rb[q] = tr_read<4 * 528>(ad); }
      asm volatile("s_waitcnt lgkmcnt(0)" ::: "memory"); SCHED;
      UNR for (int q = 0; q < 4; ++q) { const int uq = wid * 16 + j4 * 4 + q, eb = (uq & 15) * 16, sb2 = (uq >> 4) * 32;
        u32x4 o; o.x = ra[q].x; o.y = ra[q].y; o.z = rb[q].x; o.w = rb[q].y; *(u32x4*)(KWT + (size_t)(eb + li) * 256 + sb2 + 8 * lg) = o; } }
    if (tid < 256) { float s = 0.f; UNR for (int q = 0; q < 16; ++q) s += nup[q * 256 + tid]; ((float*)(p.ws + OFF_NU))[(size_t)item * 256 + tid] = s; } }
  __syncthreads();
  { u32x4 vr[16];
    UNR for (int itr = 0; itr < 16; ++itr) { const int u = tid + NTHR * itr, t = u >> 5, e0 = (u & 31) * 8; vr[itr] = __builtin_nontemporal_load((const u32x4*)(P2 + (size_t)(tok0 + t) * 3072 + 2048 + h * 256 + e0)); }
    UNR for (int itr = 0; itr < 16; ++itr) { const int u = tid + NTHR * itr, t = u >> 5, e0 = (u & 31) * 8; *(u32x4*)(Ts + t * 528 + e0 * 2) = vr[itr]; } }
  __syncthreads();
  { u16* VT = (u16*)((char*)p.out + DO_VT) + (size_t)item * 65536;
#pragma unroll 1
    for (int j4 = 0; j4 < 4; ++j4) { u32x2 ra[4], rb[4];
      UNR for (int q = 0; q < 4; ++q) { const int uq = wid * 16 + j4 * 4 + q, eb = (uq & 15) * 16, sb2 = (uq >> 4) * 32; const unsigned ad = trl + sb2 * 528 + eb * 2;
        ra[q] = tr_read<0>(ad); rb[q] = tr_read<4 * 528>(ad); }
      asm volatile("s_waitcnt lgkmcnt(0)" ::: "memory"); SCHED;
      UNR for (int q = 0; q < 4; ++q) { const int uq = wid * 16 + j4 * 4 + q, eb = (uq & 15) * 16, sb2 = (uq >> 4) * 32;
        u32x4 o; o.x = ra[q].x; o.y = ra[q].y; o.z = rb[q].x; o.w = rb[q].y; *(u32x4*)(VT + (size_t)(eb + li) * 256 + sb2 + 8 * lg) = o; } } }
}


DEV void u_item(const Params& p, char* lds, int item) {
  WLANE; lchar* shm = (lchar*)lds;
  f32x4 acc[2][2][4][2]; acc_zero(acc);
  gemm_kloop(acc, (const u16*)((char*)p.out + DO_VT) + (size_t)item * 65536, 256, (const u16*)(p.ws + OFF_KWT) + (size_t)item * 65536, 256, 256, shm);
  { RELANE; u16* rp = (u16*)(p.ws + OFF_KWT) + (size_t)item * 65536 + (size_t)ROW_(0, 0) * 256 + COLP_(0);
    UNR for (int ai = 0; ai < 2; ++ai) UNR for (int m = 0; m < 4; ++m) { u16* q = rp + (ai * 128 + m * 16) * 256; asm volatile("" : "+v"(q) :: "memory");
      UNR for (int bj = 0; bj < 2; ++bj) { const f32x4 v0 = acc[ai][bj][m][0], v1 = acc[ai][bj][m][1]; u32x4 w;
        w.x = pk_bf16(v0[0], v0[1]); w.y = pk_bf16(v0[2], v0[3]); w.z = pk_bf16(v1[0], v1[1]); w.w = pk_bf16(v1[2], v1[3]); *(u32x4*)(q + bj * 128) = w; } } }
}

DEV void phase_d1(const Params& p, char* lds) {
  const bool attn_first = (blockIdx.x >> 3) & 1;
  if (attn_first) for (int ci = blockIdx.x; ci < 768; ci += gridDim.x) attn_chunk(p, lds, ci);
  for (int item = blockIdx.x; item < 256; item += gridDim.x) { mprep_item(p, lds, item);
    asm volatile("s_waitcnt vmcnt(0)" ::: "memory"); __syncthreads();
    u_item(p, lds, item); }
#if PROBE_DUP == 20
  for (int item = blockIdx.x; item < 256; item += gridDim.x) mprep_item(p, lds, item);
#endif
#if PROBE_DUP == 21
  for (int ci = blockIdx.x; ci < 768; ci += gridDim.x) attn_chunk(p, lds, ci);
#endif
  if (!attn_first) for (int ci = blockIdx.x; ci < 768; ci += gridDim.x) attn_chunk(p, lds, ci);
}

DEV void phase_scan(const Params& p, char* lds) {
  const float* IA = (const float*)(p.ws + OFF_IA); const float* IG = (const float*)(p.ws + OFF_IG);
  const int nthreads = gridDim.x * NTHR;
  for (int gid = blockIdx.x * NTHR + ltid(); gid < 8 * 16384; gid += nthreads) {
    const int bh = gid >> 14, idx = (gid & 16383) * 4;
    f32x4 C = {0.f, 0.f, 0.f, 0.f}; float m = 0.f;
    const u16* Ub = (const u16*)(p.ws + OFF_KWT) + (size_t)(bh * 32) * 65536 + idx;
    u32x2 ua[8], ub[8];
    UNR for (int j = 0; j < 8; ++j) ua[j] = __builtin_nontemporal_load((const u32x2*)(Ub + (size_t)j * 65536));
#pragma unroll
    for (int kb = 0; kb < 4; ++kb) {
      if (kb < 3) { UNR for (int j = 0; j < 8; ++j) { const u32x2 v = __builtin_nontemporal_load((const u32x2*)(Ub + (size_t)((kb + 1) * 8 + j) * 65536)); if (kb & 1) ua[j] = v; else ub[j] = v; } }
      UNR for (int j = 0; j < 8; ++j) { const int item = bh * 32 + kb * 8 + j;
        u32x2 w; w.x = pk_bf16(C[0], C[1]); w.y = pk_bf16(C[2], C[3]);
        *(u32x2*)((u16*)(p.ws + OFF_CT) + (size_t)item * 65536 + idx) = w;
        if (idx == 0) ((float*)(p.ws + OFF_MK))[item] = m;
        const float A = IA[item], G = IG[item], mn = fmaxf(A + m, G), al = __expf(A + m - mn), be = __expf(G - mn);
        const u32x2 uv = (kb & 1) ? ub[j] : ua[j];
        const f32x4 u = {bflo(uv.x), bfhi(uv.x), bflo(uv.y), bfhi(uv.y)};
        C = C * al + u * be; m = mn; } }
  }
  for (int gid = blockIdx.x * NTHR + ltid(); gid < 2048; gid += nthreads) {
    const int bh = gid >> 8, e = gid & 255; float n = 0.f, m = 0.f;
    for (int k = 0; k < 32; ++k) { const int item = bh * 32 + k;
      ((float*)(p.ws + OFF_NK))[(size_t)item * 256 + e] = n;
      const float A = IA[item], G = IG[item], mn = fmaxf(A + m, G), al = __expf(A + m - mn), be = __expf(G - mn);
      n = n * al + ((const float*)(p.ws + OFF_NU))[(size_t)item * 256 + e] * be; m = mn; }
  }
}

DEV void mout_item(const Params& p, char* lds, int item) {
  WLANE; const int tid = ltid(); lchar* shm = (lchar*)lds;
  const int k = item & 31, h = (item >> 5) & 3, b = item >> 7; (void)k;
  const int tok0 = b * SEQ + (item & 31) * 256;
  float* sMt = (float*)(lds + 131072); float* sWin = sMt + 256; float* sCs = sWin + 256; float* sEm = sCs + 256; float* sQn = sEm + 256;
  float* sRow = sQn + 256;
  float* sR1 = (float*)lds; float* sR2 = sR1 + 1024;
  const u16* QC = (const u16*)(p.ws + OFF_QC) + (size_t)tok0 * 1024 + h * 256;
  const u16* KC = (const u16*)(p.ws + OFF_KC) + (size_t)tok0 * 1024 + h * 256;
  const float mk = ((const float*)(p.ws + OFF_MK))[item];
  __syncthreads();
  if (tid < 256) { const size_t ix = (size_t)(tok0 + tid) * 4 + h;
    const float a = ((const float*)(p.ws + OFF_SA))[ix], c = ((const float*)(p.ws + OFF_SC))[ix], cm = ((const float*)(p.ws + OFF_SCM))[ix];
    const float Mt = fmaxf(mk, cm); sMt[tid] = Mt; sWin[tid] = __expf(mk - Mt); sCs[tid] = c; sEm[tid] = __expf(-(a + Mt)); }
  { const float* NK = (const float*)(p.ws + OFF_NK) + (size_t)item * 256;
    const f32x4 nv = *(const f32x4*)(NK + lane * 4);
#pragma unroll 1
    for (int r8 = 0; r8 < 4; ++r8) { u32x2 qv[8];
      UNR for (int j = 0; j < 8; ++j) qv[j] = *(const u32x2*)(QC + (size_t)(wid * 32 + r8 * 8 + j) * 1024 + lane * 4);
      UNR for (int j = 0; j < 8; ++j) { float s = bflo(qv[j].x) * nv[0] + bfhi(qv[j].x) * nv[1] + bflo(qv[j].y) * nv[2] + bfhi(qv[j].y) * nv[3];
        s = wave_sum(s); if (lane == 0) sQn[wid * 32 + r8 * 8 + j] = s; } } }
  __syncthreads();
  f32x4 acc[2][2][4][2]; acc_zero(acc);
  gemm_kloop(acc, launder(QC), 1024, launder(KC), 1024, 256, shm);
  { RELANE; u16* PB = launder((u16*)(p.ws + OFF_PB) + (size_t)item * 65536);
    UNR for (int ai = 0; ai < 2; ++ai) UNR for (int m = 0; m < 4; ++m) { const int t = ROW_(ai, m); const float Mt = sMt[t]; float rs = 0.f;
      UNR for (int bj = 0; bj < 2; ++bj) { const int s0 = COLP_(bj); float pv[8];
        const f32x4 c0 = *(const f32x4*)(sCs + s0), c1 = *(const f32x4*)(sCs + s0 + 4);
        UNR for (int j = 0; j < 4; ++j) { const float m0 = (s0 + j <= t) ? 1.0f : 0.0f, m1 = (s0 + 4 + j <= t) ? 1.0f : 0.0f;
          pv[j] = m0 * acc[ai][bj][m][0][j] * __expf(fminf(c0[j] - Mt, 0.f)); pv[4 + j] = m1 * acc[ai][bj][m][1][j] * __expf(fminf(c1[j] - Mt, 0.f)); rs += pv[j] + pv[4 + j]; }
        u32x4 w; w.x = pk_bf16(pv[0], pv[1]); w.y = pk_bf16(pv[2], pv[3]); w.z = pk_bf16(pv[4], pv[5]); w.w = pk_bf16(pv[6], pv[7]); *(u32x4*)(PB + (size_t)t * 256 + s0) = w; }
      rs += __shfl_xor(rs, 16); rs += __shfl_xor(rs, 32);
      if (fq == 0) sRow[wc * 256 + t] = rs;
      asm volatile("" ::: "memory"); } }
  asm volatile("s_waitcnt vmcnt(0)" ::: "memory"); __syncthreads();
  acc_zero(acc);
  gemm_kloop(acc, launder(QC), 1024, launder((const u16*)(p.ws + OFF_CT) + (size_t)item * 65536), 256, 256, shm);
  { RELANE;
    UNR for (int ai = 0; ai < 2; ++ai) UNR for (int m = 0; m < 4; ++m) { const float w = sWin[ROW_(ai, m)];
      UNR for (int bj = 0; bj < 2; ++bj) UNR for (int n = 0; n < 2; ++n) acc[ai][bj][m][n] = acc[ai][bj][m][n] * w; } }
  gemm_kloop(acc, launder((const u16*)(p.ws + OFF_PB) + (size_t)item * 65536), 256, launder((const u16*)((char*)p.out + DO_VT) + (size_t)item * 65536), 256, 256, shm);
  { RELANE; const u16* P3 = launder((const u16*)(p.ws + OFF_P3) + (size_t)tok0 * 3072 + 1024 + h * 256);
    UNR for (int ai = 0; ai < 2; ++ai) { u32x4 ov[4][2];
      UNR for (int m = 0; m < 4; ++m) UNR for (int bj = 0; bj < 2; ++bj) ov[m][bj] = __builtin_nontemporal_load((const u32x4*)(P3 + (size_t)ROW_(ai, m) * 3072 + COLP_(bj)));
      UNR for (int m = 0; m < 4; ++m) { const int t = ROW_(ai, m);
        const float den = sRow[t] + sRow[256 + t] + sRow[512 + t] + sRow[768 + t] + sWin[t] * sQn[t];
        const float rden = __builtin_amdgcn_rcpf(fmaxf(fabsf(den), sEm[t])); float s1 = 0.f, s2 = 0.f;
        UNR for (int bj = 0; bj < 2; ++bj) { const u32x4 o4 = ov[m][bj];
          f32x4 v0 = acc[ai][bj][m][0] * rden, v1 = acc[ai][bj][m][1] * rden;
          v0[0] *= sigmoidf_(bflo(o4.x)); v0[1] *= sigmoidf_(bfhi(o4.x)); v0[2] *= sigmoidf_(bflo(o4.y)); v0[3] *= sigmoidf_(bfhi(o4.y));
          v1[0] *= sigmoidf_(bflo(o4.z)); v1[1] *= sigmoidf_(bfhi(o4.z)); v1[2] *= sigmoidf_(bflo(o4.w)); v1[3] *= sigmoidf_(bfhi(o4.w));
          acc[ai][bj][m][0] = v0; acc[ai][bj][m][1] = v1;
          s1 += v0[0] + v0[1] + v0[2] + v0[3] + v1[0] + v1[1] + v1[2] + v1[3];
          s2 += v0[0] * v0[0] + v0[1] * v0[1] + v0[2] * v0[2] + v0[3] * v0[3] + v1[0] * v1[0] + v1[1] * v1[1] + v1[2] * v1[2] + v1[3] * v1[3]; }
        s1 += __shfl_xor(s1, 16); s1 += __shfl_xor(s1, 32); s2 += __shfl_xor(s2, 16); s2 += __shfl_xor(s2, 32);
        if (fq == 0) { sR1[wc * 256 + t] = s1; sR2[wc * 256 + t] = s2; } }
      asm volatile("" : "+v"(acc[ai][0][0][0]), "+v"(acc[ai][0][1][0]), "+v"(acc[ai][0][2][0]), "+v"(acc[ai][0][3][0]) :: "memory"); } }
  __syncthreads();
  { RELANE; const u16* P3z = launder((const u16*)(p.ws + OFF_P3) + (size_t)tok0 * 3072 + 2048 + h * 256);
    u16* AM = launder((u16*)(p.ws + OFF_AM) + (size_t)tok0 * 1024 + h * 256); const float* gnp = launder(p.mgain + h * 256);
    f32x4 gn[2][2]; UNR for (int bj = 0; bj < 2; ++bj) { gn[bj][0] = *(const f32x4*)(gnp + COLP_(bj)); gn[bj][1] = *(const f32x4*)(gnp + COLP_(bj) + 4); }
    UNR for (int ai = 0; ai < 2; ++ai) { u32x4 zv[4][2];
      UNR for (int m = 0; m < 4; ++m) UNR for (int bj = 0; bj < 2; ++bj) zv[m][bj] = __builtin_nontemporal_load((const u32x4*)(P3z + (size_t)ROW_(ai, m) * 3072 + COLP_(bj)));
      UNR for (int m = 0; m < 4; ++m) { const int t = ROW_(ai, m);
        const float s1 = sR1[t] + sR1[256 + t] + sR1[512 + t] + sR1[768 + t], s2 = sR2[t] + sR2[256 + t] + sR2[512 + t] + sR2[768 + t];
        const float mu = s1 * (1.0f / 256.0f), var = fmaxf(s2 * (1.0f / 256.0f) - mu * mu, 0.f), rstd = rsqrtf(var + 1e-6f);
        UNR for (int bj = 0; bj < 2; ++bj) { const u32x4 z4 = zv[m][bj]; const f32x4 g0 = gn[bj][0], g1 = gn[bj][1]; const f32x4 v0 = acc[ai][bj][m][0], v1 = acc[ai][bj][m][1];
          const float y0 = (v0[0] - mu) * rstd * g0[0] * siluf_(bflo(z4.x)), y1 = (v0[1] - mu) * rstd * g0[1] * siluf_(bfhi(z4.x));
          const float y2 = (v0[2] - mu) * rstd * g0[2] * siluf_(bflo(z4.y)), y3 = (v0[3] - mu) * rstd * g0[3] * siluf_(bfhi(z4.y));
          const float y4 = (v1[0] - mu) * rstd * g1[0] * siluf_(bflo(z4.z)), y5 = (v1[1] - mu) * rstd * g1[1] * siluf_(bfhi(z4.z));
          const float y6 = (v1[2] - mu) * rstd * g1[2] * siluf_(bflo(z4.w)), y7 = (v1[3] - mu) * rstd * g1[3] * siluf_(bfhi(z4.w));
          u32x4 w; w.x = pk_bf16(y0, y1); w.y = pk_bf16(y2, y3); w.z = pk_bf16(y4, y5); w.w = pk_bf16(y6, y7); *(u32x4*)(AM + (size_t)t * 1024 + COLP_(bj)) = w; } }
      asm volatile("" ::: "memory"); } }
}

DEV void amerge_unit(const u16* __restrict__ OA, const float* __restrict__ LSE, const u16* __restrict__ P3, u16* __restrict__ AA, int u,
                     u32x4& a, u32x4& b, u32x4& c, u32x4& z, float& l0, float& l1, float& l2) {
  const int tok = u >> 7, c0 = (u & 127) * 8, h = c0 >> 7;
  l0 = LSE[(size_t)tok * 8 + h]; l1 = LSE[((size_t)NTOK + tok) * 8 + h]; l2 = LSE[((size_t)2 * NTOK + tok) * 8 + h];
  a = __builtin_nontemporal_load((const u32x4*)(OA + (size_t)tok * 1024 + c0)); b = __builtin_nontemporal_load((const u32x4*)(OA + ((size_t)NTOK + tok) * 1024 + c0)); c = __builtin_nontemporal_load((const u32x4*)(OA + ((size_t)2 * NTOK + tok) * 1024 + c0));
  z = __builtin_nontemporal_load((const u32x4*)(P3 + (size_t)tok * 3072 + c0));
}
DEV void amerge_fin(u16* __restrict__ AA, int u, const u32x4& a, const u32x4& b, const u32x4& c, const u32x4& z, float l0, float l1, float l2) {
  const int tok = u >> 7, c0 = (u & 127) * 8;
  const float mx = fmaxf(l0, fmaxf(l1, l2)); float w0 = __expf(l0 - mx), w1 = __expf(l1 - mx), w2 = __expf(l2 - mx);
  const float inv = __builtin_amdgcn_rcpf(w0 + w1 + w2); w0 *= inv; w1 *= inv; w2 *= inv;
  const unsigned au[4] = {a.x, a.y, a.z, a.w}, bu[4] = {b.x, b.y, b.z, b.w}, cu[4] = {c.x, c.y, c.z, c.w}, zu[4] = {z.x, z.y, z.z, z.w};
  unsigned o[4];
  UNR for (int e = 0; e < 4; ++e) {
    const float lo = (w0 * bflo(au[e]) + w1 * bflo(bu[e]) + w2 * bflo(cu[e])) * siluf_(bflo(zu[e]));
    const float hi = (w0 * bfhi(au[e]) + w1 * bfhi(bu[e]) + w2 * bfhi(cu[e])) * siluf_(bfhi(zu[e]));
    o[e] = pk_bf16(lo, hi); }
  u32x4 w; w.x = o[0]; w.y = o[1]; w.z = o[2]; w.w = o[3];
  *(u32x4*)(AA + (size_t)tok * 1024 + c0) = w;
}
DEV void phase_amerge(const Params& p) {
  const u16* OA = (const u16*)((char*)p.out + DO_OATT); const float* LSE = (const float*)(p.ws + OFF_LSE);
  const u16* P3 = (const u16*)(p.ws + OFF_P3); u16* AA = (u16*)(p.ws + OFF_AA);
  const int nthreads = gridDim.x * NTHR, N = NTOK * 128;
#pragma unroll 1
  for (int u = blockIdx.x * NTHR + ltid(); u < N; u += 4 * nthreads) {
    u32x4 a[4], b[4], c[4], z[4]; float l0[4], l1[4], l2[4];
    UNR for (int q = 0; q < 4; ++q) { const int uq = u + q * nthreads; if (uq < N) amerge_unit(OA, LSE, P3, AA, uq, a[q], b[q], c[q], z[q], l0[q], l1[q], l2[q]); }
    UNR for (int q = 0; q < 4; ++q) { const int uq = u + q * nthreads; if (uq < N) amerge_fin(AA, uq, a[q], b[q], c[q], z[q], l0[q], l1[q], l2[q]); }
  }
}
DEV void phase_d4(const Params& p, char* lds) {
  const bool merge_first = (blockIdx.x >> 3) & 1;
  if (merge_first) phase_amerge(p);
  for (int item = blockIdx.x; item < 256; item += gridDim.x) mout_item(p, lds, item);
#if PROBE_DUP == 22
  for (int item = blockIdx.x; item < 256; item += gridDim.x) mout_item(p, lds, item);
#endif
  if (!merge_first) phase_amerge(p);
#if PROBE_DUP == 23
  phase_amerge(p);
#endif
}

DEV size_t gate_off(int pm, int pg, int wid, int ai, int m, int bj, int lane) {
  return ((((((size_t)(pm * 16 + pg) * 8 + wid) * 2 + ai) * 4 + m) * 2 + bj) * 64 + lane) * 8;
}
DEV void phase_gemm_gates(const Params& p, char* lds) {
  const u16* H = (const u16*)(p.ws + OFF_H); const u16* W = (const u16*)(p.ws + OFF_WG); u16* P4 = (u16*)(p.ws + OFF_P4);
  gemm_stream(H, DM, W, DM, DM, 64, 16, (lchar*)lds, [=](const f32x4 (&acc)[2][2][4][2], int pm, int pn, int wr, int wc, int fr, int fq) {
    const int wid_ = wr * 4 + wc, lane_ = fq * 16 + fr;
    UNR for (int ai = 0; ai < 2; ++ai) UNR for (int m = 0; m < 4; ++m) {
      UNR for (int bj = 0; bj < 2; ++bj) { const f32x4 v0 = acc[ai][bj][m][0], v1 = acc[ai][bj][m][1]; u32x4 w;
        w.x = pk_bf16(sigmoidf_(v0[0]), sigmoidf_(v0[1])); w.y = pk_bf16(sigmoidf_(v0[2]), sigmoidf_(v0[3]));
        w.z = pk_bf16(sigmoidf_(v1[0]), sigmoidf_(v1[1])); w.w = pk_bf16(sigmoidf_(v1[2]), sigmoidf_(v1[3]));
        *(u32x4*)(P4 + gate_off(pm, pn, wid_, ai, m, bj, lane_)) = w; } }
  });
}

DEV void phase_gemm_merge(const Params& p, char* lds) {
  const u16* AA = (const u16*)(p.ws + OFF_AA); const u16* AM = (const u16*)(p.ws + OFF_AM);
  const u16* WA = (const u16*)(p.ws + OFF_WPA); const u16* WM = (const u16*)(p.ws + OFF_WPM);
  const u16* P4 = (const u16*)(p.ws + OFF_P4); u16* MG = (u16*)(p.ws + OFF_MG);
  gemm_stream2(AA, AM, 1024, WA, WM, 1024, 1024, 64, 8, (lchar*)lds, [=](f32x4 (&acc)[2][2][4][2], int pm, int pn, int seg, int wr, int wc) {
    RELANE; const u16* P4a = launder(P4); const int wid_ = wr * 4 + wc, lane_ = fq * 16 + fr;
    if (seg == 0) {
      UNR for (int ai = 0; ai < 2; ++ai) UNR for (int m = 0; m < 4; ++m) {
        UNR for (int bj = 0; bj < 2; ++bj) { const u32x4 ga = *(const u32x4*)(P4a + gate_off(pm, pn, wid_, ai, m, bj, lane_)), gb = *(const u32x4*)(P4a + gate_off(pm, 8 + pn, wid_, ai, m, bj, lane_));
          f32x4 v0 = acc[ai][bj][m][0], v1 = acc[ai][bj][m][1];
          v0[0] *= bflo(ga.x) * __builtin_amdgcn_rcpf(bflo(gb.x)); v0[1] *= bfhi(ga.x) * __builtin_amdgcn_rcpf(bfhi(gb.x)); v0[2] *= bflo(ga.y) * __builtin_amdgcn_rcpf(bflo(gb.y)); v0[3] *= bfhi(ga.y) * __builtin_amdgcn_rcpf(bfhi(gb.y));
          v1[0] *= bflo(ga.z) * __builtin_amdgcn_rcpf(bflo(gb.z)); v1[1] *= bfhi(ga.z) * __builtin_amdgcn_rcpf(bfhi(gb.z)); v1[2] *= bflo(ga.w) * __builtin_amdgcn_rcpf(bflo(gb.w)); v1[3] *= bfhi(ga.w) * __builtin_amdgcn_rcpf(bfhi(gb.w));
          acc[ai][bj][m][0] = v0; acc[ai][bj][m][1] = v1; }
        asm volatile("" : "+v"(acc[ai][0][m][0]), "+v"(acc[ai][0][m][1]), "+v"(acc[ai][1][m][0]), "+v"(acc[ai][1][m][1]) :: "memory"); }
    } else {
      UNR for (int ai = 0; ai < 2; ++ai) UNR for (int m = 0; m < 4; ++m) { const size_t ro = (size_t)(pm * 256 + ROW_(ai, m));
        UNR for (int bj = 0; bj < 2; ++bj) { const u32x4 gb = *(const u32x4*)(P4a + gate_off(pm, 8 + pn, wid_, ai, m, bj, lane_));
          const f32x4 v0 = acc[ai][bj][m][0], v1 = acc[ai][bj][m][1]; u32x4 w;
          w.x = pk_bf16(v0[0] * bflo(gb.x), v0[1] * bfhi(gb.x)); w.y = pk_bf16(v0[2] * bflo(gb.y), v0[3] * bfhi(gb.y));
          w.z = pk_bf16(v1[0] * bflo(gb.z), v1[1] * bfhi(gb.z)); w.w = pk_bf16(v1[2] * bflo(gb.w), v1[3] * bfhi(gb.w));
          *(u32x4*)(MG + ro * DM + pn * 256 + COLP_(bj)) = w; }
        asm volatile("" ::: "memory"); }
    }
  });
}

DEV void phase_gm(const Params& p, char* lds) {
  const u16* H = (const u16*)(p.ws + OFF_H); const u16* WG = (const u16*)(p.ws + OFF_WG);
  const u16* AA = (const u16*)(p.ws + OFF_AA); const u16* AM = (const u16*)(p.ws + OFF_AM);
  const u16* WA = (const u16*)(p.ws + OFF_WPA); const u16* WM = (const u16*)(p.ws + OFF_WPM);
  u16* P4 = (u16*)(p.ws + OFF_P4); u16* MG = (u16*)(p.ws + OFF_MG);
  gemm_stream_gm(H, WG, AA, AM, WA, WM, 64, 8, (lchar*)lds, [=](f32x4 (&acc)[2][2][4][2], int pm, int pn, int q, int wr, int wc) {
    RELANE; u16* P4a = launder(P4); const int wid_ = wr * 4 + wc, lane_ = fq * 16 + fr;
    if (q < 2) {
      UNR for (int ai = 0; ai < 2; ++ai) UNR for (int m = 0; m < 4; ++m) {
        UNR for (int bj = 0; bj < 2; ++bj) { const f32x4 v0 = acc[ai][bj][m][0], v1 = acc[ai][bj][m][1]; u32x4 w;
          w.x = pk_bf16(sigmoidf_(v0[0]), sigmoidf_(v0[1])); w.y = pk_bf16(sigmoidf_(v0[2]), sigmoidf_(v0[3]));
          w.z = pk_bf16(sigmoidf_(v1[0]), sigmoidf_(v1[1])); w.w = pk_bf16(sigmoidf_(v1[2]), sigmoidf_(v1[3]));
          *(u32x4*)(P4a + gate_off(pm, q * 8 + pn, wid_, ai, m, bj, lane_)) = w; } }
    } else if (q == 2) {
      UNR for (int ai = 0; ai < 2; ++ai) UNR for (int m = 0; m < 4; ++m) {
        UNR for (int bj = 0; bj < 2; ++bj) { const u32x4 ga = *(const u32x4*)(P4a + gate_off(pm, pn, wid_, ai, m, bj, lane_)), gb = *(const u32x4*)(P4a + gate_off(pm, 8 + pn, wid_, ai, m, bj, lane_));
          f32x4 v0 = acc[ai][bj][m][0], v1 = acc[ai][bj][m][1];
          v0[0] *= bflo(ga.x) * __builtin_amdgcn_rcpf(bflo(gb.x)); v0[1] *= bfhi(ga.x) * __builtin_amdgcn_rcpf(bfhi(gb.x)); v0[2] *= bflo(ga.y) * __builtin_amdgcn_rcpf(bflo(gb.y)); v0[3] *= bfhi(ga.y) * __builtin_amdgcn_rcpf(bfhi(gb.y));
          v1[0] *= bflo(ga.z) * __builtin_amdgcn_rcpf(bflo(gb.z)); v1[1] *= bfhi(ga.z) * __builtin_amdgcn_rcpf(bfhi(gb.z)); v1[2] *= bflo(ga.w) * __builtin_amdgcn_rcpf(bflo(gb.w)); v1[3] *= bfhi(ga.w) * __builtin_amdgcn_rcpf(bfhi(gb.w));
          acc[ai][bj][m][0] = v0; acc[ai][bj][m][1] = v1; }
        asm volatile("" : "+v"(acc[ai][0][m][0]), "+v"(acc[ai][0][m][1]), "+v"(acc[ai][1][m][0]), "+v"(acc[ai][1][m][1]) :: "memory"); }
    } else {
      UNR for (int ai = 0; ai < 2; ++ai) UNR for (int m = 0; m < 4; ++m) { const size_t ro = (size_t)(pm * 256 + ROW_(ai, m));
        UNR for (int bj = 0; bj < 2; ++bj) { const u32x4 gb = *(const u32x4*)(P4a + gate_off(pm, 8 + pn, wid_, ai, m, bj, lane_));
          const f32x4 v0 = acc[ai][bj][m][0], v1 = acc[ai][bj][m][1]; u32x4 w;
          w.x = pk_bf16(v0[0] * bflo(gb.x), v0[1] * bfhi(gb.x)); w.y = pk_bf16(v0[2] * bflo(gb.y), v0[3] * bfhi(gb.y));
          w.z = pk_bf16(v1[0] * bflo(gb.z), v1[1] * bfhi(gb.z)); w.w = pk_bf16(v1[2] * bflo(gb.w), v1[3] * bfhi(gb.w));
          *(u32x4*)(MG + ro * DM + pn * 256 + COLP_(bj)) = w; }
        asm volatile("" ::: "memory"); }
    }
  });
}

DEV void phase_gemm_out(const Params& p, char* lds) {
  const u16* MG = (const u16*)(p.ws + OFF_MG); const u16* WO = (const u16*)(p.ws + OFF_WOUT);
  const float* mod = (const float*)(p.ws + OFF_MOD); u16* DL = (u16*)(p.ws + OFF_DL);
  gemm_stream(MG, DM, WO, DM, DM, 64, 8, (lchar*)lds, [=](const f32x4 (&acc)[2][2][4][2], int pm, int pn, int wr, int wc, int fr, int fq) {
    const int b = (pm * 256) / SEQ;
    UNR for (int bj = 0; bj < 2; ++bj) { const int c0 = pn * 256 + COLP_(bj);
      const f32x4 g0 = *(const f32x4*)(mod + b * 6144 + 4096 + c0), g1 = *(const f32x4*)(mod + b * 6144 + 4096 + c0 + 4);
      UNR for (int ai = 0; ai < 2; ++ai) UNR for (int m = 0; m < 4; ++m) { const size_t ro = (size_t)(pm * 256 + ROW_(ai, m)) * DM + c0;
        const f32x4 v0 = g0 * acc[ai][bj][m][0], v1 = g1 * acc[ai][bj][m][1]; u32x4 w;
        w.x = pk_bf16(v0[0], v0[1]); w.y = pk_bf16(v0[2], v0[3]); w.z = pk_bf16(v1[0], v1[1]); w.w = pk_bf16(v1[2], v1[3]);
        *(u32x4*)(DL + ro) = w; } }
  });
}

DEV void phase_final(const Params& p) {
  const int wid = ltid() >> 6, lane = ltid() & 63;
  const u16* DL = (const u16*)(p.ws + OFF_DL);
#pragma unroll 1
  for (int row = (blockIdx.x * 8 + wid) * 2; row < NTOK; row += gridDim.x * 16) {
    const size_t ro = (size_t)row * DM + lane * 4;
    f32x4 xv[8], yv[8]; u32x2 dx[8], dy[8]; float ss = 0.f, st = 0.f;
    UNR for (int i = 0; i < 8; ++i) { xv[i] = *(const f32x4*)(p.x + ro + 256 * i); yv[i] = *(const f32x4*)(p.x + ro + DM + 256 * i);
      dx[i] = *(const u32x2*)(DL + ro + 256 * i); dy[i] = *(const u32x2*)(DL + ro + DM + 256 * i); }
    UNR for (int i = 0; i < 8; ++i) {
      xv[i][0] += bflo(dx[i].x); xv[i][1] += bfhi(dx[i].x); xv[i][2] += bflo(dx[i].y); xv[i][3] += bfhi(dx[i].y);
      yv[i][0] += bflo(dy[i].x); yv[i][1] += bfhi(dy[i].x); yv[i][2] += bflo(dy[i].y); yv[i][3] += bfhi(dy[i].y);
      ss += xv[i][0] * xv[i][0] + xv[i][1] * xv[i][1] + xv[i][2] * xv[i][2] + xv[i][3] * xv[i][3];
      st += yv[i][0] * yv[i][0] + yv[i][1] * yv[i][1] + yv[i][2] * yv[i][2] + yv[i][3] * yv[i][3]; }
    ss = wave_sum(ss); st = wave_sum(st);
    const float r0 = rsqrtf(ss * (1.0f / 2048.0f) + 1e-6f), r1 = rsqrtf(st * (1.0f / 2048.0f) + 1e-6f);
    UNR for (int i = 0; i < 8; ++i) { const f32x4 g = *(const f32x4*)(p.fgain + lane * 4 + 256 * i); *(f32x4*)(p.out + ro + 256 * i) = xv[i] * r0 * g; *(f32x4*)(p.out + ro + DM + 256 * i) = yv[i] * r1 * g; }
  }
}


#define XB_TMO      128
#define XB_XCNT(j)  (256  + 64 * (j))
#define XB_XSUB(j)  (1280 + 64 * (j))
#define XB_XGEN(j)  (2304 + 64 * (j))
#define XB_TOP      3328
#define XB_TOPGEN   3392
#define XCD_BAR_WORDS 3456
#define XB_SPIN_CAP (1u << 20)
DEV unsigned xb_ld(unsigned* p)              { return __hip_atomic_load(p, __ATOMIC_RELAXED, __HIP_MEMORY_SCOPE_AGENT); }
DEV unsigned xb_add(unsigned* p, unsigned v) { return __hip_atomic_fetch_add(p, v, __ATOMIC_RELAXED, __HIP_MEMORY_SCOPE_AGENT); }
DEV unsigned xb_xcc_id() { return (unsigned)__builtin_amdgcn_s_getreg((3 << 11) | 20) & 0xFu; }
#define XB_SPIN(cond, bar) do { unsigned _sp = 0; while (cond) { __builtin_amdgcn_s_sleep(1); \
    if ((++_sp & 255u) == 0u) { if (xb_ld(&(bar)[XB_TMO])) break; if (_sp > XB_SPIN_CAP) { atomicAdd(&(bar)[XB_TMO], 1u); break; } } } } while (0)
struct XcdBarrier { unsigned* bar; unsigned x; volatile LAS unsigned* st; };
DEV XcdBarrier xcd_barrier_post(unsigned* bar, volatile LAS unsigned* st) {
  XcdBarrier b; b.bar = bar; b.x = xb_xcc_id(); b.st = st;
  if (threadIdx_x_raw() == 0) (void)xb_add(&bar[XB_XCNT(b.x)], 1u);
  return b;
}
DEV void xcd_barrier_complete(unsigned* bar, unsigned x, unsigned& nloc, unsigned& nx) {
  const unsigned G = gridDim.x;
  unsigned sum, cnt, mine, sp = 0u;
  for (;;) {
    sum = 0u; cnt = 0u; mine = 0u;
#pragma unroll
    for (unsigned j = 0; j < 16; ++j) { const unsigned c = xb_ld(&bar[XB_XCNT(j)]); sum += c; cnt += (c > 0u) ? 1u : 0u; mine = (j == x) ? c : mine; }
    if (sum == G) break;
    __builtin_amdgcn_s_sleep(1);
    if ((++sp & 255u) == 0u) { if (xb_ld(&bar[XB_TMO])) break; if (sp > XB_SPIN_CAP) { atomicAdd(&bar[XB_TMO], 1u); break; } }
  }
  nloc = mine > 0u ? mine : 1u; nx = cnt > 0u ? cnt : 1u;
}
DEV void xcd_barrier(const XcdBarrier& b) {
  asm volatile("s_waitcnt vmcnt(0)" ::: "memory");
  __syncthreads();
  if (threadIdx_x_raw() == 0) {
    unsigned* bar = b.bar;
    __builtin_amdgcn_s_waitcnt(0);
    unsigned nloc = b.st[0], nx = b.st[1];
    if (nloc == 0u) { xcd_barrier_complete(bar, b.x, nloc, nx); b.st[0] = nloc; b.st[1] = nx; }
    const unsigned old = xb_add(&bar[XB_XSUB(b.x)], 1u);
    const unsigned gen = old / nloc;
    if (old + 1u == (gen + 1u) * nloc) {
      __builtin_amdgcn_fence(__ATOMIC_RELEASE, "agent");
      asm volatile("s_waitcnt vmcnt(0)" ::: "memory");
      const unsigned og = xb_add(&bar[XB_TOP], 1u);
      const unsigned tg = og / nx;
      if (og + 1u == (tg + 1u) * nx) xb_add(&bar[XB_TOPGEN], 1u);
      else XB_SPIN(xb_ld(&bar[XB_TOPGEN]) == tg, bar);
      __builtin_amdgcn_fence(__ATOMIC_ACQUIRE, "agent");
      xb_add(&bar[XB_XGEN(b.x)], 1u);
      asm volatile("s_waitcnt vmcnt(0)" ::: "memory");
    } else {
      XB_SPIN(xb_ld(&bar[XB_XGEN(b.x)]) == gen, bar);
      __builtin_amdgcn_fence(__ATOMIC_ACQUIRE, "agent");
      asm volatile("s_waitcnt vmcnt(0)" ::: "memory");
    }
  }
  __syncthreads();
}

constexpr int NPHASE = 11;
#ifndef ONE_LAUNCH
#define ONE_LAUNCH 1
#endif
#if ONE_LAUNCH
__global__ void __launch_bounds__(NTHR, 2) mega(Params p) {
  extern __shared__ __attribute__((aligned(16))) char lds[];
  cg::grid_group grid = cg::this_grid();
  volatile LAS unsigned* st = (volatile LAS unsigned*)((lchar*)lds + OFF_LDS_ST);
  if (threadIdx_x_raw() == 0) { st[0] = 0u; st[1] = 0u; }
  __syncthreads();
  const XcdBarrier xb = xcd_barrier_post((unsigned*)(p.ws + OFF_BAR), st);
  if (p.ws == nullptr) grid.sync();
  phase_prep(p, lds); xcd_barrier(xb);
  phase_h(p, lds); xcd_barrier(xb);
#if PROBE_DUP == 8
  phase_prep(p, lds); xcd_barrier(xb);
#endif
#if PROBE_DUP == 9
  phase_h(p, lds); xcd_barrier(xb);
#endif
#if PROBE_DUP == 4
  phase_prep(p, lds); xcd_barrier(xb); phase_h(p, lds); xcd_barrier(xb);
#endif
  phase_gemm_main(p, lds); xcd_barrier(xb);
#if PROBE_DUP == 1
  phase_gemm_main(p, lds); xcd_barrier(xb);
#endif
  phase_d1(p, lds); xcd_barrier(xb);
#if PROBE_DUP == 2
  phase_d1(p, lds); xcd_barrier(xb);
#endif
  phase_scan(p, lds); xcd_barrier(xb);
  phase_d4(p, lds); xcd_barrier(xb);
#if PROBE_DUP == 11
  phase_scan(p, lds); xcd_barrier(xb);
#endif
#if PROBE_DUP == 12
  phase_d4(p, lds); xcd_barrier(xb);
#endif
#if PROBE_DUP == 3
  phase_scan(p, lds); xcd_barrier(xb); phase_d4(p, lds); xcd_barrier(xb);
#endif
#if USE_GM
  phase_gm(p, lds); xcd_barrier(xb);
#else
  phase_gemm_gates(p, lds); xcd_barrier(xb);
#if PROBE_DUP == 5
  phase_gemm_gates(p, lds); xcd_barrier(xb);
#endif
  phase_gemm_merge(p, lds); xcd_barrier(xb);
#endif
#if PROBE_DUP == 6
  phase_gemm_merge(p, lds); xcd_barrier(xb);
#endif
  phase_gemm_out(p, lds); xcd_barrier(xb);
#if PROBE_DUP == 7
  phase_gemm_out(p, lds); xcd_barrier(xb);
#endif
  phase_final(p);
#if PROBE_DUP == 24
  xcd_barrier(xb); phase_final(p);
#endif
}
#define MEGA_FN mega
static void setattr_all() {}
#else
template <int PH> __global__ void __launch_bounds__(NTHR, 2) phk(Params p) {
  extern __shared__ __attribute__((aligned(16))) char lds[];
  if (PH == 0) phase_prep(p, lds);
  if (PH == 1) phase_h(p, lds);
  if (PH == 2) phase_gemm_main(p, lds);
  if (PH == 3) phase_d1(p, lds);
  if (PH == 4) { }
  if (PH == 5) phase_scan(p, lds);
  if (PH == 6) phase_d4(p, lds);
  if (PH == 7) phase_gemm_gates(p, lds);
  if (PH == 8) phase_gemm_merge(p, lds);
  if (PH == 9) phase_gemm_out(p, lds);
  if (PH == 10) phase_final(p);
}
#define MEGA_FN phk<2>
template <int PH> static void setattr_ph() { (void)hipFuncSetAttribute((const void*)phk<PH>, hipFuncAttributeMaxDynamicSharedMemorySize, LDS_BYTES); }
static void setattr_all() { setattr_ph<0>(); setattr_ph<1>(); setattr_ph<2>(); setattr_ph<3>(); setattr_ph<4>(); setattr_ph<5>(); setattr_ph<6>(); setattr_ph<7>(); setattr_ph<8>(); setattr_ph<9>(); setattr_ph<10>(); }
template <int PH> static void launch_ph(const Params& p, int grid, hipStream_t stream) {
  phk<PH><<<dim3(grid), dim3(NTHR), LDS_BYTES, stream>>>(p);
}
#endif

extern "C" void kernel_launch(void* const* d_in, const int* in_sizes, int n_in, void* d_out, int out_size, void* d_ws, size_t ws_size, hipStream_t stream) {
  static int grid = 0;
  if (!grid) {
    if (ws_size < WS_NEED || out_size != NTOK * DM || n_in != 14) { fprintf(stderr, "kernel_launch: unexpected sizes (ws %zu need %zu)\n", ws_size, (size_t)WS_NEED); grid = -1; return; }
    int dev = 0, cus = 0, per_cu = 0;
    (void)hipGetDevice(&dev); (void)hipDeviceGetAttribute(&cus, hipDeviceAttributeMultiprocessorCount, dev);
    (void)hipFuncSetAttribute((const void*)MEGA_FN, hipFuncAttributeMaxDynamicSharedMemorySize, LDS_BYTES); setattr_all();
    (void)hipOccupancyMaxActiveBlocksPerMultiprocessor(&per_cu, (const void*)MEGA_FN, NTHR, LDS_BYTES);
    if (per_cu < 1) { fprintf(stderr, "kernel_launch: occupancy query says 0 blocks per CU\n"); grid = -1; return; }
    grid = cus;
  }
  if (grid < 0) return;
  Params p{};
  p.x = (const float*)d_in[0]; p.c = (const float*)d_in[1]; p.norm_gain = (const float*)d_in[2]; p.w_ada = (const float*)d_in[3]; p.b_ada = (const float*)d_in[4];
  p.w_in = (const float*)d_in[5]; p.b_gate_if = (const float*)d_in[6]; p.conv_w = (const float*)d_in[7]; p.conv_b = (const float*)d_in[8]; p.mgain = (const float*)d_in[9];
  p.w_pa = (const float*)d_in[10]; p.w_pm = (const float*)d_in[11]; p.w_out = (const float*)d_in[12]; p.fgain = (const float*)d_in[13];
  p.out = (float*)d_out; p.ws = (char*)d_ws;
#if ONE_LAUNCH
  (void)hipMemsetAsync((char*)d_ws + OFF_BAR, 0, XCD_BAR_WORDS * 4, stream);
  void* args[] = {&p};
  hipError_t e = hipLaunchCooperativeKernel((const void*)mega, dim3(grid), dim3(NTHR), args, LDS_BYTES, stream);
  if (e != hipSuccess) fprintf(stderr, "cooperative launch failed: %s\n", hipGetErrorString(e));
#else
  launch_ph<0>(p, grid, stream); launch_ph<1>(p, grid, stream); launch_ph<2>(p, grid, stream); launch_ph<3>(p, grid, stream);
  launch_ph<4>(p, grid, stream); launch_ph<5>(p, grid, stream); launch_ph<6>(p, grid, stream); launch_ph<7>(p, grid, stream);
  launch_ph<8>(p, grid, stream); launch_ph<9>(p, grid, stream); launch_ph<10>(p, grid, stream);
#endif
}
```
